# Optimizing an MI355X kernel written in HIP

```python
import math
import jax
import jax.numpy as jnp
from jax import lax
import numpy as np

D_MODEL = 1024
BATCH = 2
SEQ = 8192
DEPTH = 4

N_MIXERS = 3
Q_BLOCK = 128
SB_HEADS = 16
SB_HEAD_DIM = D_MODEL // SB_HEADS
SB_SCALE = 1.0 / math.sqrt(SB_HEAD_DIM)
SC_WIDTH = 3
MLA_HEADS = 8
QK_NOPE = 128
QK_ROPE = 64
V_HEAD = 128
Q_LORA = 384
KV_LORA = 256
MLA_SCALE = 1.0 / math.sqrt(QK_NOPE + QK_ROPE)
ROPE_THETA = 10000.0
N_EXPERTS = 32
TOP_K = 4
D_EXPERT = D_MODEL
SWIGLU_LIMIT = 7.0
SWIGLU_ALPHA = 1.702
MOE_BLOCK = 128
LN_EPS = 1e-5
RMS_EPS = 1e-6
DEEPNORM_ALPHA = (2 * DEPTH) ** 0.25
DEEPNORM_BETA = (8 * DEPTH) ** -0.25
N_SB_LAYERS = (DEPTH - 0 + N_MIXERS - 1) // N_MIXERS
N_SC_LAYERS = (DEPTH - 1 + N_MIXERS - 1) // N_MIXERS
N_MLA_LAYERS = (DEPTH - 2 + N_MIXERS - 1) // N_MIXERS

kernel_name = "hybrid_sb_conv_mla_moe_deepnorm"


def layer_norm(x, g, b):
    xf = x.astype(jnp.float32)
    mu = jnp.mean(xf, axis=-1, keepdims=True)
    var = jnp.mean(jnp.square(xf - mu), axis=-1, keepdims=True)
    return ((xf - mu) * lax.rsqrt(var + LN_EPS)).astype(x.dtype) * g + b


def rms_norm(x, g):
    xf = x.astype(jnp.float32)
    ms = jnp.mean(jnp.square(xf), axis=-1, keepdims=True)
    return (xf * lax.rsqrt(ms + RMS_EPS)).astype(x.dtype) * g


def stick_breaking_attention(x, w_in, w_out):
    b, s, _ = x.shape
    nb = s // Q_BLOCK
    q, k, v = jnp.split(x @ w_in, 3, axis=-1)

    def to_blocks(t):
        return t.reshape(b, nb, Q_BLOCK, SB_HEADS, SB_HEAD_DIM).transpose(0, 3, 1, 2, 4)

    q = to_blocks(q) * SB_SCALE
    k = to_blocks(k)
    v = to_blocks(v)
    q_blocks = q.transpose(2, 0, 1, 3, 4)
    idx = jnp.arange(Q_BLOCK)
    strict_diag = idx[:, None] > idx[None, :]

    def query_block(args):
        qb, qblk = args

        def step(i, carry):
            acc, log_surv = carry
            kb = qb - i
            kblk = lax.dynamic_index_in_dim(k, kb, axis=2, keepdims=False)
            vblk = lax.dynamic_index_in_dim(v, kb, axis=2, keepdims=False)
            z = jnp.einsum("bhqd,bhkd->bhqk", qblk, kblk).astype(jnp.float32)
            valid = jnp.where(kb == qb, strict_diag, True)
            log_1m = jnp.where(valid, jax.nn.log_sigmoid(-z), 0.0)
            later = lax.cumsum(log_1m, axis=3, reverse=True) - log_1m
            log_a = jax.nn.log_sigmoid(z) + later + log_surv[..., None]
            a = jnp.where(valid, jnp.exp(log_a), 0.0)
            acc = acc + jnp.einsum("bhqk,bhkd->bhqd", a, vblk.astype(jnp.float32))
            return acc, log_surv + jnp.sum(log_1m, axis=-1)

        init = (jnp.zeros((b, SB_HEADS, Q_BLOCK, SB_HEAD_DIM), jnp.float32),
                jnp.zeros((b, SB_HEADS, Q_BLOCK), jnp.float32))
        acc, _ = lax.fori_loop(0, qb + 1, step, init)
        return acc

    out = lax.map(query_block, (jnp.arange(nb), q_blocks))
    out = out.transpose(1, 0, 3, 2, 4).reshape(b, s, D_MODEL).astype(x.dtype)
    return out @ w_out


def short_conv_mixer(x, w_in, conv_w, w_out):
    s = x.shape[1]
    gate_b, gate_c, h = jnp.split(x @ w_in, 3, axis=-1)
    u = gate_c * h
    u_pad = jnp.pad(u, ((0, 0), (SC_WIDTH - 1, 0), (0, 0)))
    conv = conv_w[0] * u_pad[:, 0:s]
    for j in range(1, SC_WIDTH):
        conv = conv + conv_w[j] * u_pad[:, j:j + s]
    return (gate_b * conv) @ w_out


def apply_rope(t, cos, sin):
    t1, t2 = jnp.split(t, 2, axis=-1)
    return jnp.concatenate([t1 * cos - t2 * sin, t2 * cos + t1 * sin], axis=-1)


def multi_head_latent_attention(x, positions, w_in, q_norm, w_uq, kv_norm, w_ukv, w_out):
    b, s, _ = x.shape
    nb = s // Q_BLOCK
    q_lat, kv_lat, k_rope = jnp.split(x @ w_in, [Q_LORA, Q_LORA + KV_LORA], axis=-1)
    q = (rms_norm(q_lat, q_norm) @ w_uq).reshape(b, s, MLA_HEADS, QK_NOPE + QK_ROPE)
    kv = (rms_norm(kv_lat, kv_norm) @ w_ukv).reshape(b, s, MLA_HEADS, QK_NOPE + V_HEAD)
    q_nope, q_rope = jnp.split(q, [QK_NOPE], axis=-1)
    k_nope, v = jnp.split(kv, [QK_NOPE], axis=-1)
    inv_freq = ROPE_THETA ** (-jnp.arange(0, QK_ROPE, 2, dtype=jnp.float32) / QK_ROPE)
    ang = positions.astype(jnp.float32)[..., None] * inv_freq
    cos, sin = jnp.cos(ang), jnp.sin(ang)
    q_rope = apply_rope(q_rope, cos[:, :, None], sin[:, :, None]).astype(x.dtype)
    k_rope = apply_rope(k_rope, cos, sin).astype(x.dtype)

    def to_blocks(t):
        return t.reshape(b, nb, Q_BLOCK, MLA_HEADS, t.shape[-1]).transpose(1, 0, 2, 3, 4)

    key_pos = jnp.arange(s)

    def query_block(args):
        qb, qn, qr = args
        scores = (jnp.einsum("bqhn,bkhn->bhqk", qn, k_nope)
                  + jnp.einsum("bqhr,bkr->bhqk", qr, k_rope)).astype(jnp.float32) * MLA_SCALE
        q_pos = qb * Q_BLOCK + jnp.arange(Q_BLOCK)
        scores = jnp.where(key_pos[None, :] <= q_pos[:, None], scores, -jnp.inf)
        p = jax.nn.softmax(scores, axis=-1)
        return jnp.einsum("bhqk,bkhv->bqhv", p.astype(v.dtype), v)

    out = lax.map(query_block, (jnp.arange(nb), to_blocks(q_nope), to_blocks(q_rope)))
    out = out.transpose(1, 0, 2, 3, 4).reshape(b, s, MLA_HEADS * V_HEAD)
    return out @ w_out


def routed_expert_ffn(x, router_w, router_b, w_gate, b_gate, w_up, b_up, w_down, b_down):
    b, s, d = x.shape
    n = b * s
    xt = x.reshape(n, d)
    logits = (xt @ router_w + router_b).astype(jnp.float32)
    top_logits, top_idx = lax.top_k(logits, TOP_K)
    gates = jax.nn.softmax(top_logits, axis=-1)
    flat_e = top_idx.reshape(-1)
    flat_tok = jnp.repeat(jnp.arange(n, dtype=jnp.int32), TOP_K)
    flat_g = gates.reshape(-1)
    order = jnp.argsort(flat_e)
    sorted_e = flat_e[order]
    counts = jnp.bincount(flat_e, length=N_EXPERTS)
    padded = (counts + MOE_BLOCK - 1) // MOE_BLOCK * MOE_BLOCK
    group_start = jnp.cumsum(counts) - counts
    padded_end = jnp.cumsum(padded)
    padded_start = padded_end - padded
    dest = padded_start[sorted_e] + (jnp.arange(n * TOP_K) - group_start[sorted_e])
    n_rows = n * TOP_K + N_EXPERTS * MOE_BLOCK
    n_blocks = n_rows // MOE_BLOCK
    row_tok = jnp.full((n_rows,), n, jnp.int32).at[dest].set(flat_tok[order])
    row_gate = jnp.zeros((n_rows,), jnp.float32).at[dest].set(flat_g[order])
    block_expert = jnp.minimum(
        jnp.searchsorted(padded_end, jnp.arange(n_blocks) * MOE_BLOCK, side="right"), N_EXPERTS - 1)
    x_pad = jnp.concatenate([xt, jnp.zeros((1, d), xt.dtype)], axis=0)
    rows = x_pad[row_tok].reshape(n_blocks, MOE_BLOCK, d)

    def expert_block(args):
        e, xb = args
        g = jnp.minimum(xb @ w_gate[e] + b_gate[e], SWIGLU_LIMIT)
        u = jnp.clip(xb @ w_up[e] + b_up[e], -SWIGLU_LIMIT, SWIGLU_LIMIT)
        hdn = g * jax.nn.sigmoid(SWIGLU_ALPHA * g) * (u + 1.0)
        return hdn @ w_down[e] + b_down[e]

    y = lax.map(expert_block, (block_expert, rows)).reshape(n_rows, d)
    y = y * row_gate[:, None].astype(y.dtype)
    out = jax.ops.segment_sum(y, row_tok, num_segments=n + 1)[:n]
    return out.reshape(b, s, d)


def _normal(key, shape, scale):
    return scale * jax.random.normal(key, shape, jnp.float32)


def setup_inputs(seed: int = 0) -> dict:
    key = jax.random.key(seed)
    ks = jax.random.split(key, 24)
    D = D_MODEL
    r_mla = Q_LORA + KV_LORA + QK_ROPE
    return {
        "x": _normal(ks[0], (BATCH, SEQ, D), 1.0),
        "positions": jnp.arange(SEQ, dtype=jnp.int32)[None, :]
        + jax.random.randint(ks[1], (BATCH, 1), 0, 1024, dtype=jnp.int32),
        "ln_g": 1.0 + _normal(ks[2], (DEPTH, 2, D), 0.02),
        "ln_b": _normal(ks[3], (DEPTH, 2, D), 0.02),
        "sb_w_in": _normal(ks[4], (N_SB_LAYERS, D, 3 * D), D ** -0.5),
        "sb_w_out": _normal(ks[5], (N_SB_LAYERS, D, D), DEEPNORM_BETA * D ** -0.5),
        "sc_w_in": _normal(ks[6], (N_SC_LAYERS, D, 3 * D), D ** -0.5),
        "sc_conv_w": _normal(ks[7], (N_SC_LAYERS, SC_WIDTH, D), SC_WIDTH ** -0.5),
        "sc_w_out": _normal(ks[8], (N_SC_LAYERS, D, D), DEEPNORM_BETA * D ** -0.5),
        "mla_w_in": _normal(ks[9], (N_MLA_LAYERS, D, r_mla), D ** -0.5),
        "mla_q_norm": 1.0 + _normal(ks[10], (N_MLA_LAYERS, Q_LORA), 0.02),
        "mla_w_uq": _normal(ks[11], (N_MLA_LAYERS, Q_LORA, MLA_HEADS * (QK_NOPE + QK_ROPE)), Q_LORA ** -0.5),
        "mla_kv_norm": 1.0 + _normal(ks[12], (N_MLA_LAYERS, KV_LORA), 0.02),
        "mla_w_ukv": _normal(ks[13], (N_MLA_LAYERS, KV_LORA, MLA_HEADS * (QK_NOPE + V_HEAD)), KV_LORA ** -0.5),
        "mla_w_out": _normal(ks[14], (N_MLA_LAYERS, MLA_HEADS * V_HEAD, D),
                              DEEPNORM_BETA * (MLA_HEADS * V_HEAD) ** -0.5),
        "router_w": _normal(ks[15], (DEPTH, D, N_EXPERTS), D ** -0.5),
        "router_b": _normal(ks[16], (DEPTH, N_EXPERTS), 0.01),
        "moe_w_gate": _normal(ks[17], (DEPTH, N_EXPERTS, D, D_EXPERT), D ** -0.5),
        "moe_b_gate": _normal(ks[18], (DEPTH, N_EXPERTS, D_EXPERT), 0.02),
        "moe_w_up": _normal(ks[19], (DEPTH, N_EXPERTS, D, D_EXPERT), D ** -0.5),
        "moe_b_up": _normal(ks[20], (DEPTH, N_EXPERTS, D_EXPERT), 0.02),
        "moe_w_down": _normal(ks[21], (DEPTH, N_EXPERTS, D_EXPERT, D), DEEPNORM_BETA * D_EXPERT ** -0.5),
        "moe_b_down": _normal(ks[22], (DEPTH, N_EXPERTS, D), 0.02),
    }


def reference(x, positions, ln_g, ln_b, sb_w_in, sb_w_out, sc_w_in, sc_conv_w, sc_w_out,
              mla_w_in, mla_q_norm, mla_w_uq, mla_kv_norm, mla_w_ukv, mla_w_out,
              router_w, router_b, moe_w_gate, moe_b_gate, moe_w_up, moe_b_up,
              moe_w_down, moe_b_down):
    h = x
    for layer in range(DEPTH):
        kind, slot = layer % N_MIXERS, layer // N_MIXERS
        if kind == 0:
            mix = stick_breaking_attention(h, sb_w_in[slot], sb_w_out[slot])
        elif kind == 1:
            mix = short_conv_mixer(h, sc_w_in[slot], sc_conv_w[slot], sc_w_out[slot])
        else:
            mix = multi_head_latent_attention(h, positions, mla_w_in[slot], mla_q_norm[slot],
                                              mla_w_uq[slot], mla_kv_norm[slot],
                                              mla_w_ukv[slot], mla_w_out[slot])
        h = layer_norm(DEEPNORM_ALPHA * h + mix, ln_g[layer, 0], ln_b[layer, 0])
        ffn = routed_expert_ffn(h, router_w[layer], router_b[layer], moe_w_gate[layer],
                                moe_b_gate[layer], moe_w_up[layer], moe_b_up[layer],
                                moe_w_down[layer], moe_b_down[layer])
        h = layer_norm(DEEPNORM_ALPHA * h + ffn, ln_g[layer, 1], ln_b[layer, 1])
    return h
```

```cpp
#include <hip/hip_runtime.h>
#include <cstdio>
#include <cstdint>

#ifndef MK_PER_PHASE
#define MK_PER_PHASE 0
#endif

#ifndef G3_EARLY
#define G3_EARLY true
#endif
#ifndef G4_EARLY
#define G4_EARLY true
#endif
#ifndef MOE_FP8
#define MOE_FP8 1
#endif
#define GAS __attribute__((address_space(1)))
#define LAS __attribute__((address_space(3)))
typedef unsigned short bf16;
typedef short bf16x8 __attribute__((ext_vector_type(8)));
typedef short s16x4 __attribute__((ext_vector_type(4)));
typedef float f32x4 __attribute__((ext_vector_type(4)));
typedef float f32x2 __attribute__((ext_vector_type(2)));
typedef float f32x16 __attribute__((ext_vector_type(16)));
typedef unsigned u32x4 __attribute__((ext_vector_type(4)));
typedef unsigned u32x2 __attribute__((ext_vector_type(2)));
typedef __bf16 bf16x2_t __attribute__((ext_vector_type(2)));
typedef GAS unsigned gu32;
typedef int i32x4 __attribute__((ext_vector_type(4)));
typedef int i32x8 __attribute__((ext_vector_type(8)));
typedef unsigned char u8;
constexpr int MOE_EB = MOE_FP8 ? 1 : 2;


#define RLX_AGENT __ATOMIC_RELAXED, __HIP_MEMORY_SCOPE_AGENT
#define LDS_WAIT() asm volatile("s_waitcnt lgkmcnt(0)" ::: "memory")
#define VM_WAIT() asm volatile("s_waitcnt vmcnt(0)" ::: "memory")
#define DI __device__ __forceinline__
DI unsigned pk4_fp8(float a, float b, float c, float d) { int w = 0; w = __builtin_amdgcn_cvt_pk_fp8_f32(a, b, w, false); w = __builtin_amdgcn_cvt_pk_fp8_f32(c, d, w, true); return (unsigned)w; }

DI int opq(int v) { asm volatile("" : "+v"(v)); return v; }
DI int opq_s(int v) { asm volatile("" : "+s"(v)); return v; }
template <class T> DI T* opq_p(T* p) { asm volatile("" : "+s"(p)); return p; }
DI unsigned pk2(float lo, float hi) { f32x2 v = {lo, hi}; bf16x2_t b = __builtin_convertvector(v, bf16x2_t); return __builtin_bit_cast(unsigned, b); }
DI float fp8_dec(unsigned w, int byte) { const unsigned b = (w >> (8 * byte)) & 0xffu; const float mag = __builtin_bit_cast(float, (b & 0x7fu) << 20) * 0x1p120f; return (b & 0x80u) ? -mag : mag; }
DI float bf_lo(unsigned u) { return __builtin_bit_cast(float, u << 16); }
DI float bf_hi(unsigned u) { return __builtin_bit_cast(float, u & 0xffff0000u); }
DI unsigned long long lds_ptr(LAS unsigned long long* p) { asm volatile("" ::: "memory"); const unsigned long long v = *p; const unsigned lo = __builtin_amdgcn_readfirstlane((unsigned)v), hi = __builtin_amdgcn_readfirstlane((unsigned)(v >> 32)); return ((unsigned long long)hi << 32) | lo; }
template <int CTRL> DI float dpp_f(float v) { return __builtin_bit_cast(float, __builtin_amdgcn_update_dpp(0, __builtin_bit_cast(int, v), CTRL, 0xF, 0xF, true)); }
DI float wave_sum(float v) {
    v += dpp_f<0xB1>(v);
    v += dpp_f<0x4E>(v);
    v += dpp_f<0x141>(v);
    v += dpp_f<0x140>(v);
    const int vi = __builtin_bit_cast(int, v);
    return (__builtin_bit_cast(float, __builtin_amdgcn_readlane(vi, 0)) + __builtin_bit_cast(float, __builtin_amdgcn_readlane(vi, 16))) + (__builtin_bit_cast(float, __builtin_amdgcn_readlane(vi, 32)) + __builtin_bit_cast(float, __builtin_amdgcn_readlane(vi, 48)));
}

constexpr int NTOK = 16384, DM = 1024, SEQ = 8192, NEXP = 32, TOPK = 4, ECAP = 16384;
constexpr float DN_ALPHA = 1.681792830507429f;
constexpr float LN_EPS = 1e-5f, RMS_EPS = 1e-6f;
constexpr int NWAVES = 8;

constexpr size_t MiB = 1u << 20;
constexpr size_t WS_CTL = 0, CTL_ZERO_BYTES = 1 * MiB;
constexpr size_t WS_SW = 2 * MiB;
constexpr size_t SW_SBIN = 0;
constexpr size_t SW_SBOUT = 12 * MiB;
constexpr size_t SW_SCIN = 16 * MiB;
constexpr size_t SW_SCOUT = 22 * MiB;
constexpr size_t SW_MLIN = 24 * MiB;
constexpr size_t SW_MLUQ = 26 * MiB;
constexpr size_t SW_MLUKV = 28 * MiB;
constexpr size_t SW_MLOUT = 29 * MiB;
constexpr size_t SW_ROUT = 31 * MiB;
constexpr size_t WS_HF = 34 * MiB;
constexpr size_t WS_HB = 98 * MiB;
constexpr size_t WS_MB = 130 * MiB;
constexpr size_t MB_QK = 0;
constexpr size_t MB_VT = 64 * MiB;
constexpr size_t MB_LAT = 0;
constexpr size_t MB_QLN = 24 * MiB;
constexpr size_t MB_KVLN = 36 * MiB;
constexpr size_t MB_KR = 44 * MiB;
constexpr size_t MB_CS = 46 * MiB;
constexpr size_t MB_Q = 50 * MiB;
constexpr size_t MB_KN = 98 * MiB;
constexpr size_t MB_MVT = 130 * MiB;
constexpr size_t WS_HD = 130 * MiB;
constexpr size_t WS_AO = 306 * MiB;
constexpr size_t WS_MIX = 338 * MiB;
constexpr size_t WS_Y = 370 * MiB;
constexpr size_t WS_SLOT = 498 * MiB;
constexpr size_t WS_GATE = 500 * MiB;
constexpr size_t WS_MW = 502 * MiB;
constexpr size_t MW_BUF = 192 * MiB, MW_DN = 128 * MiB;
constexpr size_t WS_XS = 886 * MiB;
constexpr size_t WS_END = 1910 * MiB;

constexpr int CW_TMO = 0;
constexpr int CW_BAR = 4096;
constexpr int CW_CNT = 8192;

constexpr int RING_BYTES = 131072;
constexpr int LDSCTL_OFF = 143360;
constexpr int LDS_BYTES = 147456;

#define XB_TMO      128
#define XB_XCNT(j)  (256  + 64 * (j))
#define XB_XSUB(j)  (1280 + 64 * (j))
#define XB_XGEN(j)  (2304 + 64 * (j))
#define XB_TOP      3328
#define XB_TOPGEN   3392
#define XCD_BAR_WORDS 3456
#define XB_SPIN_CAP (1u << 18)

DI unsigned xb_ld(unsigned* p)              { return __hip_atomic_load(p, __ATOMIC_RELAXED, __HIP_MEMORY_SCOPE_AGENT); }
DI unsigned xb_add(unsigned* p, unsigned v) { return __hip_atomic_fetch_add(p, v, __ATOMIC_RELAXED, __HIP_MEMORY_SCOPE_AGENT); }
DI unsigned xb_xcc_id() { return (unsigned)__builtin_amdgcn_s_getreg((3 << 11) | 20) & 0xFu; }
#define XB_SPIN(cond, bar) do { unsigned _sp = 0; while (cond) { __builtin_amdgcn_s_sleep(1); \
    if ((++_sp & 255u) == 0u) { if (xb_ld(&(bar)[XB_TMO])) break; if (_sp > XB_SPIN_CAP) { atomicAdd(&(bar)[XB_TMO], 1u); break; } } } } while (0)

struct XcdBarrier { unsigned* bar; unsigned x; volatile LAS unsigned* st; };

DI XcdBarrier xcd_barrier_post(unsigned* bar, volatile LAS unsigned* st) {
    XcdBarrier b; b.bar = bar; b.x = xb_xcc_id(); b.st = st;
    if (threadIdx.x == 0) (void)xb_add(&bar[XB_XCNT(b.x)], 1u);
    return b;
}
DI void xcd_barrier_complete(unsigned* bar, unsigned x, unsigned& nloc, unsigned& nx) {
    const unsigned G = gridDim.x * gridDim.y * gridDim.z;
    unsigned sum, cnt, mine, sp = 0u;
    for (;;) {
        sum = 0u; cnt = 0u; mine = 0u;
#pragma unroll
        for (unsigned j = 0; j < 16; ++j) { const unsigned c = xb_ld(&bar[XB_XCNT(j)]); sum += c; cnt += (c > 0u) ? 1u : 0u; mine = (j == x) ? c : mine; }
        if (sum == G) break;
        __builtin_amdgcn_s_sleep(1);
        if ((++sp & 255u) == 0u) { if (xb_ld(&bar[XB_TMO])) break; if (sp > XB_SPIN_CAP) { atomicAdd(&bar[XB_TMO], 1u); break; } }
    }
    nloc = mine > 0u ? mine : 1u; nx = cnt > 0u ? cnt : 1u;
}
DI void xcd_barrier(const XcdBarrier& b) {
    asm volatile("s_waitcnt vmcnt(0)" ::: "memory");
    __syncthreads();
    if (threadIdx.x == 0) {
        unsigned* bar = b.bar; unsigned bx_ = b.x;
        asm volatile("" : "+s"(bar), "+s"(bx_));
        __builtin_amdgcn_s_waitcnt(0);
        unsigned nloc = b.st[0], nx = b.st[1];
        if (nloc == 0u) { xcd_barrier_complete(bar, bx_, nloc, nx); b.st[0] = nloc; b.st[1] = nx; }
        const unsigned old = xb_add(&bar[XB_XSUB(bx_)], 1u);
        const unsigned gen = old / nloc;
        if (old + 1u == (gen + 1u) * nloc) {
            __builtin_amdgcn_fence(__ATOMIC_RELEASE, "agent");
            asm volatile("s_waitcnt vmcnt(0)" ::: "memory");
            const unsigned og = xb_add(&bar[XB_TOP], 1u);
            const unsigned tg = og / nx;
            if (og + 1u == (tg + 1u) * nx) xb_add(&bar[XB_TOPGEN], 1u);
            else XB_SPIN(xb_ld(&bar[XB_TOPGEN]) == tg, bar);
            __builtin_amdgcn_fence(__ATOMIC_ACQUIRE, "agent");
            xb_add(&bar[XB_XGEN(bx_)], 1u);
            asm volatile("s_waitcnt vmcnt(0)" ::: "memory");
        } else {
            XB_SPIN(xb_ld(&bar[XB_XGEN(bx_)]) == gen, bar);
            __builtin_amdgcn_fence(__ATOMIC_ACQUIRE, "agent");
            asm volatile("s_waitcnt vmcnt(0)" ::: "memory");
        }
    }
    __syncthreads();
}

namespace pg8 {
constexpr int BM = 256, BK = 64, HALF = 128, HTB = HALF * BK * 2, STAGE_BYTES = 8 * HTB, NXCD = 8, WGM = 8;
DI int lds_byte(int r, int c) { const int st = (r >> 4) * 2 + (c >> 5), rr = r & 15, cc = c & 31, ob = rr * 64 + cc * 2; return st * 1024 + (ob ^ (((ob >> 9) & 1) << 5)); }
DI void stage_rc(int b, int& R, int& C) { const int st = b / 1024, sb = b % 1024, swz = sb ^ (((sb >> 9) & 1) << 5); R = (st >> 1) * 16 + swz / 64; C = (st & 1) * 32 + (swz % 64) / 2; }
DI int perm32(int rho) { const int n = rho >> 4, i = rho & 15; return 8 * (i >> 2) + 4 * n + (i & 3); }

struct Unit { int arow, orow, ocol, e, pos0, cnt; const u8* bt; };

struct StaticOrder {
    static constexpr bool GATHER = false;
    int nM, nN, nwg, G, c, Kb; const u8* Bt;
    DI void init(int M, int N, int K_, const bf16* Bt_, int G_, int c_) { nM = M / BM; nN = N / BM; nwg = nM * nN; G = G_; c = opq_s(c_); Kb = 2 * K_; Bt = (const u8*)Bt_; }
    DI bool next(int i, Unit& u) const {
        const long L = (long)i * G + c; if (L >= nwg) return false;
        int wgid = (int)L; { const int q = nwg / NXCD, r = nwg % NXCD, xcd = wgid % NXCD, off = wgid / NXCD; wgid = (xcd < r ? xcd * (q + 1) : r * (q + 1) + (xcd - r) * q) + off; }
        const int nig = WGM * nN, gid = wgid / nig, fm = gid * WGM, gsz = (nM - fm) < WGM ? (nM - fm) : WGM;
        const int pm = fm + ((wgid % nig) % gsz), pn = (wgid % nig) / gsz;
        u.arow = pm * BM; u.orow = pm * BM; u.ocol = pn * BM; u.e = 0; u.pos0 = 0; u.cnt = 0; u.bt = Bt + (size_t)pn * BM * Kb; return true;
    }
};
template <bool GATHER_>
struct MoeOrderT {
    static constexpr bool GATHER = GATHER_;
    const LAS int* tb; const LAS int* cnt; int NP, G, c, Kb, hd_a; const u8* wt; size_t estride; const unsigned long long* sg;
    DI bool next(int i, Unit& u) const {
        const int L = i * G + opq_s(c), gi = L / NP; const int total = __builtin_amdgcn_readfirstlane(tb[32]) * NP, e = __builtin_amdgcn_readfirstlane(tb[176 + (gi < 320 ? gi : 0)]);
        if (L >= total) return false;
        const int t0 = __builtin_amdgcn_readfirstlane(tb[e]), mte = __builtin_amdgcn_readfirstlane(tb[e + 1]) - t0; const int r = L - t0 * NP; const int pn = r / mte, mt = r - pn * mte;
        u.e = e; u.pos0 = mt * BM; u.cnt = __builtin_amdgcn_readfirstlane(cnt[e]);
        u.arow = hd_a ? (t0 + mt) * BM : GATHER ? 0 : e * ECAP + mt * BM;
        u.orow = (t0 + mt) * BM; u.ocol = pn * BM;
        u.bt = wt + (size_t)e * estride + (size_t)pn * BM * Kb; return true;
    }
};

DI unsigned cvt_pk_bf16(float lo, float hi) { return pk2(lo, hi); }

struct EpiBf16 {
    static constexpr bool PERM = true;
    bf16* O; int ldc; float scale;
    static constexpr bool EARLY = false;
    struct Pre { };
    DI void pre_dma(LAS unsigned char*, const Unit&, int, int) const { }
    DI void pre_lds(Pre&, const LAS unsigned char*, const Unit&, int, int, int, int) const { }
    DI void pre(Pre&, const Unit&, int, int, int, int) const { }
    DI void run(const f32x4 (&acc)[2][2][4][2], const Unit& u, int wr, int wc, int fr, int fq, const Pre&) const {
        const int row0 = u.orow + wr * 64 + fr, col0 = u.ocol + wc * 32 + 8 * fq;
#pragma unroll
        for (int ai = 0; ai < 2; ++ai)
#pragma unroll
            for (int m = 0; m < 4; ++m) { bf16* rowp = O + (size_t)(row0 + ai * HALF + m * 16) * ldc + col0;
#pragma unroll
                for (int bj = 0; bj < 2; ++bj) { const f32x4 v0 = acc[ai][bj][m][0] * scale, v1 = acc[ai][bj][m][1] * scale;
                    u32x4 w; w.x = cvt_pk_bf16(v0[0], v0[1]); w.y = cvt_pk_bf16(v0[2], v0[3]); w.z = cvt_pk_bf16(v1[0], v1[1]); w.w = cvt_pk_bf16(v1[2], v1[3]);
                    *(u32x4*)(rowp + bj * HALF) = w; } }
    }
};
struct EpiSwiGLU {
    static constexpr bool PERM = true;
    bf16* HD; const float* bg; const float* bu;
    static constexpr bool EARLY = G3_EARLY;
    struct Pre { f32x4 gv[2], uv[2]; };
    DI void pre_dma(LAS unsigned char* aux, const Unit& u, int wid, int lane) const {
        if (wid < 4) { const float* src = bg; if (wid >= 2) src = bu; src += u.e * 1024 + (u.ocol >> 1) + 64 * (wid & 1);
            unsigned vo_ = (unsigned)lane * 4u; asm volatile("" : "+v"(vo_));
            __builtin_amdgcn_global_load_lds((const unsigned*)((const char*)src + vo_), (LAS unsigned*)(aux + wid * 256), 4, 0, 0); } }
    DI void pre_lds(Pre& P, const LAS unsigned char* aux, const Unit&, int, int wc, int, int fq) const { const int jl = wc * 32 + 8 * fq;
#pragma unroll
        for (int n = 0; n < 2; ++n) { P.gv[n] = *(const LAS f32x4*)(aux + (jl + 4 * n) * 4); P.uv[n] = *(const LAS f32x4*)(aux + 512 + (jl + 4 * n) * 4); } }
    DI void pre(Pre& P, const Unit& u, int, int wc, int, int fq) const { const int j0 = (u.ocol >> 1) + wc * 32 + 8 * fq;
#pragma unroll
        for (int n = 0; n < 2; ++n) { P.gv[n] = *(const f32x4*)(bg + u.e * 1024 + j0 + 4 * n); P.uv[n] = *(const f32x4*)(bu + u.e * 1024 + j0 + 4 * n); } }
    DI void run(const f32x4 (&acc)[2][2][4][2], const Unit& u, int wr, int wc, int fr, int fq, const Pre& P) const {
        const int row0 = u.orow + wr * 64 + fr, j0 = (u.ocol >> 1) + wc * 32 + 8 * fq;
        const f32x4 (&gv)[2] = P.gv; const f32x4 (&uv)[2] = P.uv;
#pragma unroll
        for (int ai = 0; ai < 2; ++ai)
#pragma unroll
            for (int m = 0; m < 4; ++m) { const size_t eo = (size_t)(row0 + ai * HALF + m * 16) * 1024 + j0; float h[8];
#pragma unroll
                for (int n = 0; n < 2; ++n) {
                    f32x4 g4 = acc[ai][0][m][n] + gv[n], u4 = acc[ai][1][m][n] + uv[n];
                    g4 = __builtin_elementwise_min(g4, (f32x4){7.f, 7.f, 7.f, 7.f});
                    u4 = __builtin_elementwise_min(__builtin_elementwise_max(u4, (f32x4){-7.f, -7.f, -7.f, -7.f}), (f32x4){7.f, 7.f, 7.f, 7.f});
                    const f32x4 x4 = g4 * (-1.702f * 1.4426950408889634f); f32x4 d4;
#pragma unroll
                    for (int v = 0; v < 4; ++v) d4[v] = __builtin_amdgcn_exp2f(x4[v]);
                    d4 = d4 + 1.0f; f32x4 r4;
#pragma unroll
                    for (int v = 0; v < 4; ++v) r4[v] = __builtin_amdgcn_rcpf(d4[v]);
                    const f32x4 h4 = (g4 * r4) * (u4 + 1.0f);
#pragma unroll
                    for (int v = 0; v < 4; ++v) h[4 * n + v] = h4[v]; }
                if constexpr (MOE_FP8) { u32x2 w; w.x = pk4_fp8(h[0], h[1], h[2], h[3]); w.y = pk4_fp8(h[4], h[5], h[6], h[7]); *(u32x2*)((u8*)HD + eo) = w; }
                else { u32x4 w; w.x = cvt_pk_bf16(h[0], h[1]); w.y = cvt_pk_bf16(h[2], h[3]); w.z = cvt_pk_bf16(h[4], h[5]); w.w = cvt_pk_bf16(h[6], h[7]); *(u32x4*)(HD + eo) = w; } }
    }
};
struct EpiDown {
    static constexpr bool PERM = true;
    u8* Y; const float* bd; const unsigned long long* sg;
    static constexpr bool EARLY = G4_EARLY;
    struct Pre { f32x4 bv[2][2]; unsigned long long rec[2][4]; };
    DI void pre_dma(LAS unsigned char* aux, const Unit& u, int wid, int lane) const {
        if (wid < 4) { const float* src = bd + u.e * 1024 + u.ocol + 64 * wid; unsigned vo_ = (unsigned)lane * 4u; asm volatile("" : "+v"(vo_));
            __builtin_amdgcn_global_load_lds((const unsigned*)((const char*)src + vo_), (LAS unsigned*)(aux + wid * 256), 4, 0, 0); }
        else { const int w4 = wid - 4, pos = u.pos0 + 64 * w4 + lane; const unsigned* src = (const unsigned*)(sg + (size_t)u.e * ECAP + (pos < u.cnt ? pos : u.cnt - 1));
            __builtin_amdgcn_global_load_lds(src, (LAS unsigned*)(aux + 1024 + w4 * 256), 4, 0, 0); __builtin_amdgcn_global_load_lds(src + 1, (LAS unsigned*)(aux + 2048 + w4 * 256), 4, 0, 0); } }
    DI void pre_lds(Pre& P, const LAS unsigned char* aux, const Unit&, int wr, int wc, int fr, int fq) const { const int cl = wc * 32 + 8 * fq;
#pragma unroll
        for (int bj = 0; bj < 2; ++bj)
#pragma unroll
            for (int n = 0; n < 2; ++n) P.bv[bj][n] = *(const LAS f32x4*)(aux + (cl + bj * HALF + 4 * n) * 4);
#pragma unroll
        for (int ai = 0; ai < 2; ++ai)
#pragma unroll
            for (int m = 0; m < 4; ++m) { const int r = ai * HALF + wr * 64 + m * 16 + fr; const unsigned lo = *(const LAS unsigned*)(aux + 1024 + 4 * r), hi = *(const LAS unsigned*)(aux + 2048 + 4 * r);
                P.rec[ai][m] = (unsigned long long)lo | ((unsigned long long)hi << 32); } }
    DI void pre(Pre& P, const Unit& u, int wr, int wc, int fr, int fq) const { const int col0 = u.ocol + wc * 32 + 8 * fq;
#pragma unroll
        for (int bj = 0; bj < 2; ++bj)
#pragma unroll
            for (int n = 0; n < 2; ++n) P.bv[bj][n] = *(const f32x4*)(bd + u.e * 1024 + col0 + bj * HALF + 4 * n);
#pragma unroll
        for (int ai = 0; ai < 2; ++ai)
#pragma unroll
            for (int m = 0; m < 4; ++m) { const int pos = u.pos0 + ai * HALF + wr * 64 + m * 16 + fr; P.rec[ai][m] = sg[u.e * ECAP + (pos < u.cnt ? pos : u.cnt - 1)]; } }
    DI void run(const f32x4 (&acc)[2][2][4][2], const Unit& u, int wr, int wc, int fr, int fq, const Pre& P) const {
        const int col0 = u.ocol + wc * 32 + 8 * fq;
        const f32x4 (&bv)[2][2] = P.bv; const unsigned long long (&rec)[2][4] = P.rec;
#pragma unroll
        for (int ai = 0; ai < 2; ++ai)
#pragma unroll
            for (int m = 0; m < 4; ++m) { const int pos = u.pos0 + ai * HALF + wr * 64 + m * 16 + fr;
                if (pos < u.cnt) { const int slot = (int)(unsigned)rec[ai][m]; const float g = __builtin_bit_cast(float, (unsigned)(rec[ai][m] >> 32)) * 16.0f; u8* rowp = Y + (size_t)slot * 1024 + col0;
#pragma unroll
                    for (int bj = 0; bj < 2; ++bj) { const f32x4 v0 = (acc[ai][bj][m][0] + bv[bj][0]) * g, v1 = (acc[ai][bj][m][1] + bv[bj][1]) * g;
                        u32x2 w; w.x = pk4_fp8(v0[0], v0[1], v0[2], v0[3]); w.y = pk4_fp8(v1[0], v1[1], v1[2], v1[3]);
                        *(u32x2*)(rowp + bj * HALF) = w; } } }
    }
};

template <class Epi, class Sched, bool F8>
DI void gemm_phase(LAS unsigned char* lds, const void* A_, int Kb, const Sched& S, const Epi& E) {
    const u8* A = (const u8*)A_;
    const int tid = opq((int)threadIdx.x), wid = __builtin_amdgcn_readfirstlane(tid >> 6), lane = tid & 63, wr = wid >> 2, wc = wid & 3, fr = lane & 15, fq = lane >> 4;
    const int nt = Kb / (2 * BK);
    unsigned voffA[2], voffB[2];
#pragma unroll
    for (int i = 0; i < 2; ++i) { int R, C; stage_rc(tid * 16 + i * 8192, R, C); const int Rb = Epi::PERM ? ((R & ~31) + perm32(R & 31)) : R;
        voffA[i] = (unsigned)(R * Kb + C * 2); voffB[i] = (unsigned)(Rb * Kb + C * 2); }
    const size_t kstep = (size_t)(BK * 2);
    const size_t hstep = (size_t)HALF * Kb;
    unsigned gofc[2][2], recn[2][2];
#define PG8_RECN(u) do { _Pragma("unroll") for (int h_ = 0; h_ < 2; ++h_) _Pragma("unroll") for (int i_ = 0; i_ < 2; ++i_) { const int R_ = (int)(voffA[i_] >> 10) + HALF * h_, p_ = (u).pos0 + R_; \
        const GAS unsigned* rp_ = (const GAS unsigned*)(S.sg + (size_t)(u).e * ECAP + (p_ < (u).cnt ? p_ : (u).cnt - 1)); \
        asm volatile("global_load_dword %0, %1, off" : "=v"(recn[h_][i_]) : "v"(rp_) : "memory"); } } while (0)
#define PG8_ROFF(r, i) ((((r) >> 2) * 1024u) + (voffA[i] & 1023u))
#define PG8_GOFF(g, u) do { unsigned rr_[2][2];     \
        _Pragma("unroll") for (int h_ = 0; h_ < 2; ++h_) _Pragma("unroll") for (int i_ = 0; i_ < 2; ++i_) { const int R_ = (int)(voffA[i_] >> 10) + HALF * h_, p_ = (u).pos0 + R_; \
            rr_[h_][i_] = *((const GAS unsigned*)(S.sg + (size_t)(u).e * ECAP + (p_ < (u).cnt ? p_ : (u).cnt - 1))); }     \
        _Pragma("unroll") for (int h_ = 0; h_ < 2; ++h_) _Pragma("unroll") for (int i_ = 0; i_ < 2; ++i_) g[h_][i_] = (rr_[h_][i_] >> 2) * 1024u + (voffA[i_] & 1023u); } while (0)
    const unsigned ldsw = (unsigned)wid * 1024u;
    const int aoff = lds_byte(wr * 64 + fr, fq * 8), boff = lds_byte(wc * 32 + fr, fq * 8);
#define PG8_SA(b, h) (((b) * 2 + (h)) * HTB)
#define PG8_SB(b, h) ((4 + (b) * 2 + (h)) * HTB)
#define PG8_STAGE(bufoff, gbase, voff) do { _Pragma("unroll") for (int _i = 0; _i < 2; ++_i) { unsigned vo_ = (voff)[_i]; asm volatile("" : "+v"(vo_));     \
        __builtin_amdgcn_global_load_lds((const unsigned*)((const char*)(gbase) + vo_), (LAS unsigned*)(lds + (bufoff) + ldsw + _i * 8192), 16, 0, 0); } } while (0)
#define PG8_STAGE_G(bufoff, gbase, nx, h) do { _Pragma("unroll") for (int _i = 0; _i < 2; ++_i) { unsigned r_ = recn[h][_i]; asm volatile("" : "+v"(r_));     \
        unsigned vo_ = (nx) ? PG8_ROFF(r_, _i) : gofc[h][_i]; asm volatile("" : "+v"(vo_)); \
        __builtin_amdgcn_global_load_lds((const unsigned*)((const char*)(gbase) + vo_), (LAS unsigned*)(lds + (bufoff) + ldsw + _i * 8192), 16, 0, 0); } } while (0)
#define PG8_STA(bufoff, gbase, nx, h) do { if constexpr (Sched::GATHER) PG8_STAGE_G(bufoff, gbase, nx, h); else PG8_STAGE(bufoff, (gbase) + (h) * hstep, voffA); } while (0)
#define PG8_LDA(dst, b, h) do { _Pragma("unroll") for (int m = 0; m < 4; ++m) _Pragma("unroll") for (int k = 0; k < 2; ++k) dst[m][k] = *(const LAS bf16x8*)(lds + PG8_SA(b, h) + aoff + m * 2048 + k * 1024); } while (0)
#define PG8_LDB(dst, b, h) do { _Pragma("unroll") for (int n = 0; n < 2; ++n) _Pragma("unroll") for (int k = 0; k < 2; ++k) dst[n][k] = *(const LAS bf16x8*)(lds + PG8_SB(b, h) + boff + n * 2048 + k * 1024); } while (0)
#define PG8_CAT(x) __builtin_shufflevector(__builtin_bit_cast(i32x4, x[0]), __builtin_bit_cast(i32x4, x[1]), 0, 1, 2, 3, 4, 5, 6, 7)
#define PG8_MMA(ai, bj, At, Bt) do { __builtin_amdgcn_s_setprio(1); _Pragma("unroll") for (int m = 0; m < 4; ++m) _Pragma("unroll") for (int n = 0; n < 2; ++n) { \
        if constexpr (F8) { const i32x8 b8_ = PG8_CAT(Bt[n]), a8_ = PG8_CAT(At[m]);     \
            asm("s_nop 1\n\tv_mfma_scale_f32_16x16x128_f8f6f4 %0, %1, %2, %0, %3, %4 op_sel_hi:[0,0,0]" : "+v"(acc[ai][bj][m][n]) : "v"(b8_), "v"(a8_), "v"(sc_w), "v"(sc_x)); } \
        else { _Pragma("unroll") for (int k = 0; k < 2; ++k) acc[ai][bj][m][n] = __builtin_amdgcn_mfma_f32_16x16x32_bf16(Bt[n][k], At[m][k], acc[ai][bj][m][n], 0, 0, 0); } } \
        __builtin_amdgcn_s_setprio(0); } while (0)
#define PG8_WAIT_V(n) asm volatile("s_waitcnt vmcnt(" #n ")" ::: "memory")
#define PG8_WAIT_L(n) asm volatile("s_waitcnt lgkmcnt(" #n ")" ::: "memory")
#define PG8_BAR __builtin_amdgcn_s_barrier()
#define PG8_SCHED __builtin_amdgcn_sched_barrier(0)
    int sc_w = 121, sc_x = 127;
    if constexpr (F8) asm volatile("" : "+v"(sc_w), "+v"(sc_x));
    Unit cur, nxt; int ui = 0;
    if (!S.next(0, cur)) return;
    f32x4 acc[2][2][4][2];
#pragma unroll
    for (int a = 0; a < 2; ++a)
#pragma unroll
        for (int b = 0; b < 2; ++b)
#pragma unroll
            for (int m = 0; m < 4; ++m)
#pragma unroll
                for (int n = 0; n < 2; ++n) acc[a][b][m][n] = (f32x4){0.f, 0.f, 0.f, 0.f};
    bf16x8 At[4][2], B0[2][2], B1[2][2];
    const char* cA = (const char*)A + (size_t)cur.arow * Kb; const char* cB = (const char*)cur.bt;
    if constexpr (Sched::GATHER) PG8_GOFF(gofc, cur);
    PG8_STAGE(PG8_SB(0, 0), cB, voffB); PG8_STAGE(PG8_SB(0, 1), cB + hstep, voffB); PG8_STA(PG8_SA(0, 0), cA, false, 0); PG8_STA(PG8_SA(0, 1), cA, false, 1);
    if (wr == 1) PG8_BAR;
    PG8_WAIT_V(2); PG8_BAR;
    PG8_STAGE(PG8_SB(1, 0), cB + kstep, voffB); PG8_STA(PG8_SA(1, 0), cA + kstep, false, 0); PG8_STAGE(PG8_SB(1, 1), cB + hstep + kstep, voffB);
    PG8_WAIT_V(6); PG8_BAR;
    for (;;) {
        const bool has_next = S.next(ui + 1, nxt);
        const char* nA = has_next ? (const char*)A + (size_t)nxt.arow * Kb : cA; const char* nB = has_next ? (const char*)nxt.bt : cB;
        if constexpr (Sched::GATHER) { Unit un_ = cur; if (has_next) un_ = nxt; PG8_RECN(un_); }
#pragma nounroll
        for (int t = 0; t < nt; t += 2) {
            const bool last = (t == nt - 2);
            if constexpr (Epi::EARLY) { if (last) E.pre_dma(lds + STAGE_BYTES, cur, wid, lane); }
            const char* a1 = cA + (size_t)(t + 1) * kstep;
            const char* a2 = last ? nA : cA + (size_t)(t + 2) * kstep; const char* b2 = last ? nB : cB + (size_t)(t + 2) * kstep;
            const char* a3 = a2 + kstep; const char* b3 = b2 + kstep;
            PG8_LDB(B0, 0, 0); PG8_LDB(B1, 0, 1); PG8_SCHED; PG8_LDA(At, 0, 0); PG8_STA(PG8_SA(1, 1), a1, false, 1);
            PG8_WAIT_V(8); PG8_WAIT_L(0); PG8_BAR; PG8_MMA(0, 0, At, B0); PG8_MMA(0, 1, At, B1); PG8_BAR; PG8_SCHED;
            PG8_LDA(At, 0, 1); PG8_STAGE(PG8_SB(0, 0), b2, voffB); PG8_STAGE(PG8_SB(0, 1), b2 + hstep, voffB); PG8_STA(PG8_SA(0, 0), a2, last, 0);
            PG8_WAIT_V(8); PG8_WAIT_L(0); PG8_BAR; PG8_MMA(1, 0, At, B0); PG8_MMA(1, 1, At, B1); PG8_BAR; PG8_SCHED;
            PG8_LDB(B0, 1, 0); PG8_LDB(B1, 1, 1); PG8_SCHED; PG8_LDA(At, 1, 0); PG8_STA(PG8_SA(0, 1), a2, last, 1);
            PG8_WAIT_V(8); PG8_WAIT_L(0); PG8_BAR; PG8_MMA(0, 0, At, B0); PG8_MMA(0, 1, At, B1); PG8_BAR; PG8_SCHED;
            PG8_LDA(At, 1, 1); PG8_STAGE(PG8_SB(1, 0), b3, voffB); PG8_STAGE(PG8_SB(1, 1), b3 + hstep, voffB); PG8_STA(PG8_SA(1, 0), a3, last, 0);
            PG8_WAIT_V(8); PG8_WAIT_L(0); PG8_BAR; PG8_MMA(1, 0, At, B0); PG8_MMA(1, 1, At, B1); PG8_BAR; PG8_SCHED;
        }
        if (wr == 0) PG8_BAR;
        if constexpr (F8) asm volatile("s_nop 15\n\ts_nop 15" ::: "memory");
        { typename Epi::Pre P; if constexpr (Epi::EARLY) E.pre_lds(P, lds + STAGE_BYTES, cur, wr, wc, fr, fq); else E.pre(P, cur, wr, wc, fr, fq);
          E.run(acc, cur, wr, wc, fr, fq, P); }
        if (!has_next) break;
#pragma unroll
        for (int a = 0; a < 2; ++a)
#pragma unroll
            for (int b = 0; b < 2; ++b)
#pragma unroll
                for (int m = 0; m < 4; ++m)
#pragma unroll
                    for (int n = 0; n < 2; ++n) acc[a][b][m][n] = (f32x4){0.f, 0.f, 0.f, 0.f};
        cur = nxt; cA = nA; cB = nB; ++ui;
        if constexpr (Sched::GATHER) { _Pragma("unroll") for (int h_ = 0; h_ < 2; ++h_) _Pragma("unroll") for (int i_ = 0; i_ < 2; ++i_) { unsigned r_ = recn[h_][i_]; asm volatile("" : "+v"(r_)); gofc[h_][i_] = PG8_ROFF(r_, i_); } }
        if (wr == 1) PG8_BAR;
    }
    PG8_WAIT_V(0);
    PG8_BAR;
#undef PG8_SA
#undef PG8_SB
#undef PG8_STAGE
#undef PG8_STAGE_G
#undef PG8_STA
#undef PG8_GOFF
#undef PG8_RECN
#undef PG8_ROFF
#undef PG8_LDA
#undef PG8_LDB
#undef PG8_MMA
#undef PG8_CAT
#undef PG8_WAIT_V
#undef PG8_WAIT_L
#undef PG8_BAR
#undef PG8_SCHED
}
}

struct Frame {
    LAS unsigned char* lds;
    LAS int* LC;
    gu32* ctl;
    unsigned char* ws;
    int tid, lane, wave, vcu, G;
};

DI void cvt_tile(const float* W, int N, bf16* WT, int ldt, int k0, int n0, int drow0, LAS float* scr, int lane_) {
    const int lane = opq(lane_);
    const int kr = lane >> 4, c4 = lane & 15;
#pragma unroll 4
    for (int i = 0; i < 16; ++i) { const int kk = 4 * i + kr;
        const f32x4 v = *(const GAS f32x4*)(W + (size_t)(k0 + kk) * N + n0 + 4 * c4);
        LAS float* d = scr + kk * 65 + 4 * c4; d[0] = v.x; d[1] = v.y; d[2] = v.z; d[3] = v.w; }
    LDS_WAIT();
    const int c = lane & 7, nr = lane >> 3;
#pragma unroll
    for (int j = 0; j < 8; ++j) { const int n = nr + 8 * j; const LAS float* s = scr + (8 * c) * 65 + n;
        u32x4 o; o.x = pk2(s[0], s[65]); o.y = pk2(s[130], s[195]); o.z = pk2(s[260], s[325]); o.w = pk2(s[390], s[455]);
        *(GAS u32x4*)(WT + (size_t)(drow0 + n) * ldt + k0 + 8 * c) = o; }
    LDS_WAIT();
}
DI void cvt_tile_f8(const float* W, int N, u8* WT, int ldt, int k0, int n0, int drow0, LAS float* scr, int lane_) {
    const int lane = opq(lane_);
    const int kr = lane >> 4, c4 = lane & 15;
    f32x4 v[16];
#pragma unroll
    for (int i = 0; i < 16; ++i) v[i] = __builtin_nontemporal_load((const GAS f32x4*)(W + (size_t)(k0 + 4 * i + kr) * N + n0 + 4 * c4));
#pragma unroll
    for (int i = 0; i < 16; ++i) { LAS float* d = scr + (4 * i + kr) * 65 + 4 * c4; d[0] = v[i].x; d[1] = v[i].y; d[2] = v[i].z; d[3] = v[i].w; }
    LDS_WAIT();
    const int c = lane & 3, nr = lane >> 2;
#pragma unroll
    for (int j = 0; j < 4; ++j) { const int n = nr + 16 * j; const LAS float* s = scr + (16 * c) * 65 + n;
        u32x4 o; o.x = pk4_fp8(s[0] * 64.f, s[65] * 64.f, s[130] * 64.f, s[195] * 64.f); o.y = pk4_fp8(s[260] * 64.f, s[325] * 64.f, s[390] * 64.f, s[455] * 64.f);
        o.z = pk4_fp8(s[520] * 64.f, s[585] * 64.f, s[650] * 64.f, s[715] * 64.f); o.w = pk4_fp8(s[780] * 64.f, s[845] * 64.f, s[910] * 64.f, s[975] * 64.f);
        *(GAS u32x4*)(WT + (size_t)(drow0 + n) * ldt + k0 + 16 * c) = o; }
    LDS_WAIT();
}
enum { MAP_ID = 0, MAP_GATE = 1, MAP_UP = 2, MAP_UKV = 3 };
DI int map_row(int kind, int n0) {
    if (kind == MAP_GATE) return (n0 >> 7) * 256 + (n0 & 127);
    if (kind == MAP_UP) return (n0 >> 7) * 256 + 128 + (n0 & 127);
    if (kind == MAP_UKV) { const int hh = n0 >> 8, c = n0 & 255; return c < 128 ? hh * 128 + c : 1024 + hh * 128 + (c - 128); }
    return n0;
}
DI void cvt_matrix(Frame& F, const float* W, int K, int N, bf16* WT, int kind, int& base) {
    const int NGW = F.G * NWAVES, gw = opq_s(F.vcu * NWAVES + F.wave), nk = K / 64, nn = N / 64, nit = nk * nn;
    LAS float* scr = (LAS float*)(F.lds + F.wave * 16640);
    int first = (gw - base % NGW + NGW) % NGW;
    for (int it = first; it < nit; it += NGW) { const int kb = it / nn, nb = it - kb * nn; cvt_tile(W, N, WT, K, 64 * kb, 64 * nb, map_row(kind, 64 * nb), scr, F.lane); }
    base += nit;
}
DI void cvt_moe_range(Frame& F, const float* wg, const float* wu, const float* wd, int layer, bf16* buf, int k0, int k1, int base) {
    const int NGW = F.G * NWAVES, gw = opq_s(F.vcu * NWAVES + F.wave);
    LAS float* scr = (LAS float*)(F.lds + F.wave * 16640);
    const size_t lo = (size_t)layer * NEXP * 1024 * 1024;
    for (int k = k0; k < k1; ++k) {
        const int it = base + gw + NGW * k; if (it >= 3 * NEXP * 256) break;
        const int mat = it >> 8, t = it & 255, kb = t >> 4, nb = t & 15, which = mat / NEXP, e = mat - which * NEXP;
        const float* W = (which == 0 ? wg : which == 1 ? wu : wd) + lo + (size_t)e * 1024 * 1024;
        const int drow = map_row(which == 0 ? MAP_GATE : which == 1 ? MAP_UP : MAP_ID, 64 * nb);
        if constexpr (MOE_FP8) { u8* WT = which == 2 ? (u8*)buf + MW_DN + (size_t)e * 1024 * 1024 : (u8*)buf + (size_t)e * 2048 * 1024; cvt_tile_f8(W, 1024, WT, 1024, 64 * kb, 64 * nb, drow, scr, F.lane); }
        else { bf16* WT = which == 2 ? (bf16*)((u8*)buf + MW_DN) + (size_t)e * 1024 * 1024 : buf + (size_t)e * 2048 * 1024; cvt_tile(W, 1024, WT, 1024, 64 * kb, 64 * nb, drow, scr, F.lane); }
    }
}
DI void cvt_moe_stream(Frame& F, const float* wg, const float* wu, const float* wd, int layer, u8* buf, int first, int step, int count) {
    const int lane = opq(F.lane), kr = lane >> 4, c4 = lane & 15, c = lane & 3, nr = lane >> 2;
    LAS float* scr = (LAS float*)(F.lds + F.wave * 16640);
    const size_t lo = (size_t)layer * NEXP * 1024 * 1024;
    f32x4 va[16], vb[16];
    const unsigned voff = (unsigned)(kr * 1024 + 4 * c4) * 4u;
#define CS_SRC(it_) ((((it_) >> 8) / NEXP == 0 ? wg : ((it_) >> 8) / NEXP == 1 ? wu : wd) + lo + (size_t)(((it_) >> 8) % NEXP) * 1024 * 1024 + (size_t)(64 * (((it_) & 255) >> 4)) * 1024 + 64 * ((it_) & 15))
#define CS_LOAD(V, it_) do { const float* W_ = CS_SRC(it_); _Pragma("unroll") for (int i = 0; i < 16; ++i) { const float* b_ = W_ + (size_t)(4 * i) * 1024;     \
        asm volatile("global_load_dwordx4 %0, %1, %2 nt" : "=v"(V[i]) : "v"(voff), "s"(b_) : "memory"); } } while (0)
#define CS_WAIT(V, N) asm volatile("s_waitcnt vmcnt(" #N ")" : "+v"(V[0]), "+v"(V[1]), "+v"(V[2]), "+v"(V[3]), "+v"(V[4]), "+v"(V[5]), "+v"(V[6]), "+v"(V[7]), \
        "+v"(V[8]), "+v"(V[9]), "+v"(V[10]), "+v"(V[11]), "+v"(V[12]), "+v"(V[13]), "+v"(V[14]), "+v"(V[15]) :: "memory")
#define CS_PROC(V, it_) do { const int mat_ = (it_) >> 8, t_ = (it_) & 255, kb_ = t_ >> 4, nb_ = t_ & 15, which_ = mat_ / NEXP, e_ = mat_ - which_ * NEXP; \
        u8* WT_ = which_ == 2 ? buf + MW_DN + (size_t)e_ * 1024 * 1024 : buf + (size_t)e_ * 2048 * 1024; \
        const int drow_ = map_row(which_ == 0 ? MAP_GATE : which_ == 1 ? MAP_UP : MAP_ID, 64 * nb_); \
        _Pragma("unroll") for (int i = 0; i < 16; ++i) { LAS float* d = scr + (4 * i + kr) * 65 + 4 * c4; d[0] = V[i].x; d[1] = V[i].y; d[2] = V[i].z; d[3] = V[i].w; } \
        LDS_WAIT(); \
        _Pragma("unroll") for (int j = 0; j < 4; ++j) { const int n = nr + 16 * j; const LAS float* s = scr + (16 * c) * 65 + n; \
            u32x4 o; o.x = pk4_fp8(s[0] * 64.f, s[65] * 64.f, s[130] * 64.f, s[195] * 64.f); o.y = pk4_fp8(s[260] * 64.f, s[325] * 64.f, s[390] * 64.f, s[455] * 64.f); \
            o.z = pk4_fp8(s[520] * 64.f, s[585] * 64.f, s[650] * 64.f, s[715] * 64.f); o.w = pk4_fp8(s[780] * 64.f, s[845] * 64.f, s[910] * 64.f, s[975] * 64.f); \
            *(GAS u32x4*)(WT_ + (size_t)(drow_ + n) * 1024 + 64 * kb_ + 16 * c) = o; } \
        LDS_WAIT(); } while (0)
    if (count <= 0) return;
    CS_LOAD(va, first);
    for (int k = 0; k < count; k += 2) {
        const int ita = first + step * k, itb = ita + step, itc = (k + 2 < count) ? itb + step : itb;
        CS_LOAD(vb, itb); CS_WAIT(va, 16);
        CS_PROC(va, ita);
        CS_LOAD(va, itc); CS_WAIT(vb, 16);
        CS_PROC(vb, itb);
    }
    CS_WAIT(va, 0);
#undef CS_SRC
#undef CS_WAIT
#undef CS_LOAD
#undef CS_PROC
}
DI void cvt_moe_layer(Frame& F, const float* wg, const float* wu, const float* wd, int layer, bf16* buf, int base) {
    base = __builtin_amdgcn_readfirstlane(base);
    cvt_moe_range(F, wg, wu, wd, layer, buf, 0, (3 * NEXP * 256 - base + F.G * NWAVES - 1) / (F.G * NWAVES), base);
}

DI void ln_rows_finish(f32x4 (&v)[4], const float* g, const float* b, int lane) {
    float s = 0.f;
#pragma unroll
    for (int j = 0; j < 4; ++j) s += (v[j].x + v[j].y) + (v[j].z + v[j].w);
    const float mean = wave_sum(s) * (1.f / DM); float s2 = 0.f;
#pragma unroll
    for (int j = 0; j < 4; ++j) { v[j] = v[j] - mean; s2 += (v[j].x * v[j].x + v[j].y * v[j].y) + (v[j].z * v[j].z + v[j].w * v[j].w); }
    const float rstd = 1.f / sqrtf(wave_sum(s2) * (1.f / DM) + LN_EPS);
#pragma unroll
    for (int j = 0; j < 4; ++j) { const f32x4 gg = *(const GAS f32x4*)(g + 4 * lane + 256 * j), bb = *(const GAS f32x4*)(b + 4 * lane + 256 * j); v[j] = v[j] * rstd * gg + bb; }
}

DI void ln_pair_finish(f32x4 (&a)[4], f32x4 (&c)[4], const f32x4 (&gg)[4], const f32x4 (&bb)[4]) {
    float sa = 0.f, sc = 0.f;
#pragma unroll
    for (int j = 0; j < 4; ++j) { sa += (a[j].x + a[j].y) + (a[j].z + a[j].w); sc += (c[j].x + c[j].y) + (c[j].z + c[j].w); }
    sa = wave_sum(sa); sc = wave_sum(sc);
    const float ma = sa * (1.f / DM), mc = sc * (1.f / DM); float qa = 0.f, qc = 0.f;
#pragma unroll
    for (int j = 0; j < 4; ++j) { a[j] = a[j] - ma; c[j] = c[j] - mc; qa += (a[j].x * a[j].x + a[j].y * a[j].y) + (a[j].z * a[j].z + a[j].w * a[j].w); qc += (c[j].x * c[j].x + c[j].y * c[j].y) + (c[j].z * c[j].z + c[j].w * c[j].w); }
    qa = wave_sum(qa); qc = wave_sum(qc);
    const float ra = __builtin_amdgcn_rsqf(qa * (1.f / DM) + LN_EPS), rc = __builtin_amdgcn_rsqf(qc * (1.f / DM) + LN_EPS);
#pragma unroll
    for (int j = 0; j < 4; ++j) { a[j] = a[j] * ra * gg[j] + bb[j]; c[j] = c[j] * rc * gg[j] + bb[j]; }
}

#define MFMA32(a, b, c) __builtin_amdgcn_mfma_f32_32x32x16_bf16((a), (b), (c), 0, 0, 0)
constexpr int SBL_KP = 144, SBL_VP = 1056, SBL_KB = 512 * SBL_KP;
DI void sb_attn_block(Frame& F, const bf16* QK, const bf16* Vt, bf16* AO, int b, int h, int qb8, int cit, const float* cwg, const float* cwu, const float* cwd, int clayer, u8* cbuf) {
    const int tid = opq(F.tid), lane = tid & 63, w = F.wave, j = lane & 31, G = lane >> 5;
    const int pj = 16 * ((j >> 2) & 1) + 4 * (j >> 3) + (j & 3);
    LAS unsigned char* kimg = F.lds; LAS unsigned char* vimg = F.lds + SBL_KB;
    const int q0 = qb8 * 256, kbase = q0 - 256;
    const size_t tokb = (size_t)b * SEQ;
    const int t0 = q0 + 32 * w;
    const size_t tokq = tokb + t0 + j;
    bf16x8 qf[4];
#pragma unroll
    for (int s = 0; s < 4; ++s) qf[s] = *(const GAS bf16x8*)(QK + tokq * 2048 + h * 64 + 16 * s + 8 * G);
    {
        u32x4 kv[8], vv[8];
#pragma unroll
        for (int i = 0; i < 8; ++i) { const int id = tid + 512 * i, row = id >> 3, c = id & 7; const int kpos = kbase + row < 0 ? 0 : kbase + row;
            kv[i] = *(const GAS u32x4*)(QK + (tokb + kpos) * 2048 + 1024 + h * 64 + 8 * c); }
#pragma unroll
        for (int i = 0; i < 8; ++i) { const int id = tid + 512 * i, row = id >> 6, c = id & 63; const int kpos = kbase + 8 * c < 0 ? 0 : kbase + 8 * c;
            vv[i] = *(const GAS u32x4*)(Vt + (size_t)(h * 64 + row) * NTOK + tokb + kpos); }
        __syncthreads();
#pragma unroll
        for (int i = 0; i < 8; ++i) { const int id = tid + 512 * i, row = id >> 3, c = id & 7; *(LAS u32x4*)(kimg + row * SBL_KP + (row & 16) + 16 * c) = kv[i]; }
#pragma unroll
        for (int i = 0; i < 8; ++i) { const int id = tid + 512 * i, row = id >> 6, c = id & 63; *(LAS u32x4*)(vimg + row * SBL_VP + (row & 16) + 16 * c) = vv[i]; }
    }
    __syncthreads();
    asm volatile("" ::: "memory");
    unsigned long long cv[32];
    {
        const int ci = cit >= 0 ? cit : 0, mat = ci >> 8, t_ = ci & 255, kb_ = t_ >> 4, nb_ = t_ & 15, which = mat / NEXP, e_ = mat - which * NEXP;
        const float* W_ = (which == 0 ? cwg : which == 1 ? cwu : cwd) + (size_t)clayer * NEXP * 1024 * 1024 + (size_t)e_ * 1024 * 1024 + (size_t)(64 * kb_ + 32 * (w & 1)) * 1024 + 64 * nb_;
#pragma unroll
        for (int kk = 0; kk < 32; ++kk) cv[kk] = __builtin_nontemporal_load((const GAS unsigned long long*)(W_ + (size_t)kk * 1024) + lane);
    }
    asm volatile("" ::: "memory");
    f32x16 o0, o1;
#pragma unroll
    for (int i = 0; i < 16; ++i) { o0[i] = 0.f; o1[i] = 0.f; }
    float carry = 1.f;
    auto tile = [&](const bf16x8 (&kf)[4], const bf16x8 (&vf)[2][2], int kb) __attribute__((always_inline)) -> bool {
        f32x16 z;
#pragma unroll
        for (int i = 0; i < 16; ++i) z[i] = 0.f;
#pragma unroll
        for (int s = 0; s < 4; ++s) z = MFMA32(kf[s], qf[s], z);
        const bool diag = (kb == t0);
        z = z * (0.125f * 1.4426950408889634f);
        float r[16];
#pragma unroll
        for (int i = 0; i < 16; ++i) { z[i] = __builtin_amdgcn_exp2f(fminf(z[i], 60.f)); r[i] = __builtin_amdgcn_rcpf(1.0f + z[i]); }
        if (diag) {
#pragma unroll
            for (int i = 0; i < 16; ++i) r[i] = (16 * G + i) < j ? r[i] : 1.f; }
#pragma unroll
        for (int i = 14; i >= 0; --i) r[i] = r[i + 1] * r[i];
        const float ptot = __shfl_xor(r[0], 32);
        const float base = (G == 0 ? ptot : 1.f) * carry;
        float a[16];
#pragma unroll
        for (int i = 0; i < 16; ++i) a[i] = z[i] * (r[i] * base);
        if (diag) {
#pragma unroll
            for (int i = 0; i < 16; ++i) a[i] = (16 * G + i) < j ? a[i] : 0.f; }
        carry *= r[0] * ptot;
        bf16x8 af[2];
#pragma unroll
        for (int sp = 0; sp < 2; ++sp) { u32x4 p; p.x = pk2(a[8 * sp], a[8 * sp + 1]); p.y = pk2(a[8 * sp + 2], a[8 * sp + 3]); p.z = pk2(a[8 * sp + 4], a[8 * sp + 5]); p.w = pk2(a[8 * sp + 6], a[8 * sp + 7]);
            af[sp] = __builtin_bit_cast(bf16x8, p); }
#pragma unroll
        for (int sp = 0; sp < 2; ++sp) { o0 = MFMA32(vf[0][sp], af[sp], o0); o1 = MFMA32(vf[1][sp], af[sp], o1); }
        return __all(carry == 0.f);
    };
    int kb = t0; bool stop = false;
    for (; kb >= 0 && kb >= kbase; kb -= 32) {
        bf16x8 kf[4], vf[2][2];
        const int lt = (kb - kbase) >> 5;
        const LAS unsigned char* kp = kimg + (lt * 32 + pj) * SBL_KP + (pj & 16) + 16 * G;
#pragma unroll
        for (int s = 0; s < 4; ++s) kf[s] = *(const LAS bf16x8*)(kp + 32 * s);
#pragma unroll
        for (int r = 0; r < 2; ++r)
#pragma unroll
            for (int sp = 0; sp < 2; ++sp) vf[r][sp] = *(const LAS bf16x8*)(vimg + (32 * r + pj) * SBL_VP + (pj & 16) + (lt * 32 + 16 * G + 8 * sp) * 2);
        if (tile(kf, vf, kb)) { stop = true; break; }
    }
    if (!stop)
    for (; kb >= 0; kb -= 32) {
        bf16x8 kf[4], vf[2][2];
        const size_t tokk = tokb + kb + pj;
#pragma unroll
        for (int s = 0; s < 4; ++s) kf[s] = *(const GAS bf16x8*)(QK + tokk * 2048 + 1024 + h * 64 + 16 * s + 8 * G);
#pragma unroll
        for (int r = 0; r < 2; ++r)
#pragma unroll
            for (int sp = 0; sp < 2; ++sp) vf[r][sp] = *(const GAS bf16x8*)(Vt + (size_t)(h * 64 + 32 * r + pj) * NTOK + tokb + kb + 16 * G + 8 * sp);
        if (tile(kf, vf, kb)) break;
    }
    bf16* orow = AO + tokq * 1024 + h * 64 + 16 * G;
#pragma unroll
    for (int hf = 0; hf < 2; ++hf) {
        u32x4 w0, w1;
        w0.x = pk2(o0[8 * hf], o0[8 * hf + 1]); w0.y = pk2(o0[8 * hf + 2], o0[8 * hf + 3]); w0.z = pk2(o0[8 * hf + 4], o0[8 * hf + 5]); w0.w = pk2(o0[8 * hf + 6], o0[8 * hf + 7]);
        w1.x = pk2(o1[8 * hf], o1[8 * hf + 1]); w1.y = pk2(o1[8 * hf + 2], o1[8 * hf + 3]); w1.z = pk2(o1[8 * hf + 4], o1[8 * hf + 5]); w1.w = pk2(o1[8 * hf + 6], o1[8 * hf + 7]);
        *(GAS u32x4*)(orow + 8 * hf) = w0; *(GAS u32x4*)(orow + 32 + 8 * hf) = w1; }
    if (cit >= 0) {
        const int mat = cit >> 8, t_ = cit & 255, kb_ = t_ >> 4, nb_ = t_ & 15, which = mat / NEXP, e_ = mat - which * NEXP;
        const int drow = map_row(which == 0 ? MAP_GATE : which == 1 ? MAP_UP : MAP_ID, 64 * nb_);
        u8* WT_ = cbuf + (which == 2 ? MW_DN + (size_t)e_ * 1024 * 1024 : (size_t)e_ * 2048 * 1024) + (size_t)(drow + 2 * lane) * 1024 + 64 * kb_ + 32 * (w & 1);
#pragma unroll
        for (int c4 = 0; c4 < 2; ++c4) { u32x4 o0_, o1_;
#pragma unroll
            for (int q = 0; q < 4; ++q) {
                o0_[q] = pk4_fp8(__builtin_bit_cast(float, (unsigned)cv[16 * c4 + 4 * q]) * 64.f, __builtin_bit_cast(float, (unsigned)cv[16 * c4 + 4 * q + 1]) * 64.f,
                                 __builtin_bit_cast(float, (unsigned)cv[16 * c4 + 4 * q + 2]) * 64.f, __builtin_bit_cast(float, (unsigned)cv[16 * c4 + 4 * q + 3]) * 64.f);
                o1_[q] = pk4_fp8(__builtin_bit_cast(float, (unsigned)(cv[16 * c4 + 4 * q] >> 32)) * 64.f, __builtin_bit_cast(float, (unsigned)(cv[16 * c4 + 4 * q + 1] >> 32)) * 64.f,
                                 __builtin_bit_cast(float, (unsigned)(cv[16 * c4 + 4 * q + 2] >> 32)) * 64.f, __builtin_bit_cast(float, (unsigned)(cv[16 * c4 + 4 * q + 3] >> 32)) * 64.f); }
            *(GAS u32x4*)(WT_ + 16 * c4) = o0_; *(GAS u32x4*)(WT_ + 1024 + 16 * c4) = o1_; }
    }
}
constexpr int SB_CV = 4;
constexpr int MLA_KP = 416, MLA_VP = 160;
constexpr int MLA_KB = 64 * MLA_KP, MLA_VB = 128 * MLA_VP;
constexpr float MLA_C = 0.07216878364870322f * 1.4426950408889634f;
DI void mla_attn_unit(Frame& F, const bf16* Q, const bf16* Kn, const bf16* KR, const bf16* Vt, const float* CS, bf16* AO, int b, int hh, int qb) {
    const int tid = opq(F.tid), lane = tid & 63, w = F.wave, j = lane & 31, G = lane >> 5;
    const int pj = 16 * ((j >> 2) & 1) + 4 * (j >> 3) + (j & 3);
    LAS unsigned char* kbuf = F.lds; LAS unsigned char* vbuf = F.lds + 2 * MLA_KB;
    const int q0 = qb * 256, qrow = q0 + 32 * w + j;
    const size_t tokq = (size_t)b * SEQ + qrow;
    bf16x8 qf[12];
#pragma unroll
    for (int s = 0; s < 8; ++s) qf[s] = *(const GAS bf16x8*)(Q + tokq * 1536 + hh * 192 + 16 * s + 8 * G);
    {
        const bf16* qr = Q + tokq * 1536 + hh * 192 + 128; const float* cs = CS + tokq * 64;
#pragma unroll
        for (int s = 8; s < 12; ++s) { const int e0 = 16 * (s - 8) + 8 * G, f0 = e0 & 31;
            const u32x4 t1 = *(const GAS u32x4*)(qr + f0), t2 = *(const GAS u32x4*)(qr + 32 + f0);
            const f32x4 c0 = *(const GAS f32x4*)(cs + f0), c1 = *(const GAS f32x4*)(cs + f0 + 4), s0 = *(const GAS f32x4*)(cs + 32 + f0), s1 = *(const GAS f32x4*)(cs + 32 + f0 + 4);
            float o[8];
#pragma unroll
            for (int k = 0; k < 4; ++k) { const unsigned a1 = t1[k], a2 = t2[k];
                const float x1 = bf_lo(a1), y1 = bf_hi(a1), x2 = bf_lo(a2), y2 = bf_hi(a2);
                const float cx = (2 * k < 4) ? c0[2 * k] : c1[2 * k - 4], cy = (2 * k + 1 < 4) ? c0[2 * k + 1] : c1[2 * k + 1 - 4];
                const float sx = (2 * k < 4) ? s0[2 * k] : s1[2 * k - 4], sy = (2 * k + 1 < 4) ? s0[2 * k + 1] : s1[2 * k + 1 - 4];
                if (e0 < 32) { o[2 * k] = x1 * cx - x2 * sx; o[2 * k + 1] = y1 * cy - y2 * sy; }
                else         { o[2 * k] = x2 * cx + x1 * sx; o[2 * k + 1] = y2 * cy + y1 * sy; } }
            u32x4 p; p.x = pk2(o[0], o[1]); p.y = pk2(o[2], o[3]); p.z = pk2(o[4], o[5]); p.w = pk2(o[6], o[7]); qf[s] = __builtin_bit_cast(bf16x8, p); }
    }
    f32x16 o[4];
#pragma unroll
    for (int r = 0; r < 4; ++r)
#pragma unroll
        for (int i = 0; i < 16; ++i) o[r][i] = 0.f;
    float m = -1e30f, l = 0.f;
    const int ntile = (q0 + 256) / 64;
    u32x4 sk[3], sv[2];
    const size_t tokb = (size_t)b * SEQ;
    unsigned ofk[3], ofv[2];
#pragma unroll
    for (int i_ = 0; i_ < 2; ++i_) { const int id = tid + 512 * i_; ofk[i_] = (unsigned)((id >> 4) * 1024 + 8 * (id & 15)) * 2u; }
    ofk[2] = (unsigned)((tid >> 3) * 64 + 8 * (tid & 7)) * 2u;
#pragma unroll
    for (int i_ = 0; i_ < 2; ++i_) { const int id = tid + 512 * i_; ofv[i_] = (unsigned)((id >> 3) * NTOK + 8 * (id & 7)) * 2u; }
#define MLA_LD1(dst, base, off) do { unsigned vo_ = (off); asm volatile("" : "+v"(vo_)); dst = *(const GAS u32x4*)((const char*)(base) + vo_); } while (0)
#define MLA_LOAD(t) do { const int kb_ = (t) * 64; const bf16* kn_ = Kn + (tokb + kb_) * 1024 + hh * 128; const bf16* kr_ = KR + (tokb + kb_) * 64; const bf16* vt_ = Vt + (size_t)(hh * 128) * NTOK + tokb + kb_; \
        MLA_LD1(sk[0], kn_, ofk[0]); MLA_LD1(sk[1], kn_, ofk[1]); MLA_LD1(sk[2], kr_, ofk[2]); MLA_LD1(sv[0], vt_, ofv[0]); MLA_LD1(sv[1], vt_, ofv[1]); } while (0)
#define MLA_STORE(buf) do { \
        _Pragma("unroll") for (int i_ = 0; i_ < 2; ++i_) { const int id = tid + 512 * i_, row = id >> 4, c = id & 15; *(LAS u32x4*)(kbuf + (buf) * MLA_KB + row * MLA_KP + (row & 16) + 16 * c) = sk[i_]; } \
        { const int row = tid >> 3, c = 16 + (tid & 7); *(LAS u32x4*)(kbuf + (buf) * MLA_KB + row * MLA_KP + (row & 16) + 16 * c) = sk[2]; } \
        _Pragma("unroll") for (int i_ = 0; i_ < 2; ++i_) { const int id = tid + 512 * i_, row = id >> 3, c = id & 7; \
            *(LAS u32x4*)(vbuf + (buf) * MLA_VB + row * MLA_VP + (row & 16) + 16 * c) = sv[i_]; } } while (0)
    __syncthreads();
    MLA_LOAD(0); MLA_STORE(0);
    __syncthreads();
    for (int t = 0; t < ntile; ++t) {
        const int buf = t & 1, kb = t * 64;
        if (t + 1 < ntile) MLA_LOAD(t + 1);
        const int wq0 = q0 + 32 * w;
        if (kb <= wq0 + 31) {
            const bool need_mask = (kb + 63 > wq0);
            f32x16 s0, s1;
#pragma unroll
            for (int i = 0; i < 16; ++i) { s0[i] = 0.f; s1[i] = 0.f; }
            const LAS unsigned char* kp = kbuf + buf * MLA_KB + pj * MLA_KP + (pj & 16) + 16 * G;
            {
                bf16x8 ka = *(const LAS bf16x8*)(kp), kb = *(const LAS bf16x8*)(kp + 32 * MLA_KP);
#pragma unroll
                for (int s = 0; s < 12; ++s) { bf16x8 na = ka, nb = kb;
                    if (s < 11) { na = *(const LAS bf16x8*)(kp + 32 * (s + 1)); nb = *(const LAS bf16x8*)(kp + 32 * MLA_KP + 32 * (s + 1)); }
                    __builtin_amdgcn_sched_barrier(0);
                    s0 = MFMA32(ka, qf[s], s0); s1 = MFMA32(kb, qf[s], s1);
                    __builtin_amdgcn_sched_barrier(0);
                    ka = na; kb = nb; }
            }
            float mx = -1e30f;
            if (need_mask) {
#pragma unroll
                for (int i = 0; i < 16; ++i) { const int key = kb + 16 * G + i; if (key > qrow) s0[i] = -1e30f; if (key + 32 > qrow) s1[i] = -1e30f; } }
#pragma unroll
            for (int i = 0; i < 16; ++i) mx = fmaxf(mx, fmaxf(s0[i], s1[i]));
            mx = fmaxf(mx, __shfl_xor(mx, 32));
            const float mn = fmaxf(m, mx); const float nmc = -mn * MLA_C;
            float ps = 0.f;
#pragma unroll
            for (int i = 0; i < 16; ++i) { const float p0 = __builtin_amdgcn_exp2f(__builtin_fmaf(s0[i], MLA_C, nmc)), p1 = __builtin_amdgcn_exp2f(__builtin_fmaf(s1[i], MLA_C, nmc)); s0[i] = p0; s1[i] = p1; ps += p0 + p1; }
            if (__any(mn != m)) {
                const float alpha = __builtin_amdgcn_exp2f((m - mn) * MLA_C); l *= alpha;
#pragma unroll
                for (int r = 0; r < 4; ++r)
#pragma unroll
                    for (int i = 0; i < 16; ++i) o[r][i] *= alpha;
            }
            m = mn; l += ps;
            const LAS unsigned char* vp = vbuf + buf * MLA_VB + pj * MLA_VP + (pj & 16) + 32 * G;
            {
                bf16x8 af[4];
#pragma unroll
                for (int q = 0; q < 4; ++q) { const f32x16& pp = (q >> 1) ? s1 : s0; const int sp = q & 1;
                    u32x4 p; p.x = pk2(pp[8 * sp], pp[8 * sp + 1]); p.y = pk2(pp[8 * sp + 2], pp[8 * sp + 3]); p.z = pk2(pp[8 * sp + 4], pp[8 * sp + 5]); p.w = pk2(pp[8 * sp + 6], pp[8 * sp + 7]);
                    af[q] = __builtin_bit_cast(bf16x8, p); }
#define MLA_VF(idx) (*(const LAS bf16x8*)(vp + 32 * ((idx) & 3) * MLA_VP + (32 * ((idx) >> 3) + 8 * (((idx) >> 2) & 1)) * 2))
                bf16x8 vf = MLA_VF(0);
#pragma unroll
                for (int idx = 0; idx < 16; ++idx) { bf16x8 nv = vf;
                    if (idx < 15) nv = MLA_VF(idx + 1);
                    __builtin_amdgcn_sched_barrier(0);
                    o[idx & 3] = MFMA32(vf, af[idx >> 2], o[idx & 3]);
                    __builtin_amdgcn_sched_barrier(0);
                    vf = nv; }
#undef MLA_VF
            }
        }
        if (t + 1 < ntile) MLA_STORE(buf ^ 1);
        __syncthreads();
    }
#undef MLA_LOAD
#undef MLA_LD1
#undef MLA_STORE
    l += __shfl_xor(l, 32);
    const float inv = 1.0f / l;
    bf16* orow = AO + tokq * 1024 + hh * 128 + 16 * G;
#pragma unroll
    for (int r = 0; r < 4; ++r)
#pragma unroll
        for (int hf = 0; hf < 2; ++hf) { u32x4 wv; wv.x = pk2(o[r][8 * hf] * inv, o[r][8 * hf + 1] * inv); wv.y = pk2(o[r][8 * hf + 2] * inv, o[r][8 * hf + 3] * inv);
            wv.z = pk2(o[r][8 * hf + 4] * inv, o[r][8 * hf + 5] * inv); wv.w = pk2(o[r][8 * hf + 6] * inv, o[r][8 * hf + 7] * inv);
            *(GAS u32x4*)(orow + 32 * r + 8 * hf) = wv; }
}

struct Args { const void* in[23]; float* out; unsigned char* ws; int ph_lo, ph_hi; };
static_assert(sizeof(Args) == 23 * 8 + 8 + 8 + 8, "Args has no padding");

constexpr int PH_PER_LAYER = 9;
constexpr int CVT_QUOTA = 4;
constexpr int CVT_P6_UNUSED = 16384;
constexpr int N_PHASES = 1 + 4 * PH_PER_LAYER;

__global__ void __launch_bounds__(NWAVES * 64, 2) mk_fwd(Args args) {
    extern __shared__ __attribute__((aligned(16))) unsigned char lds[];
    Frame F;
    F.lds = (LAS unsigned char*)lds; F.LC = (LAS int*)(F.lds + LDSCTL_OFF);
    F.tid = threadIdx.x; F.lane = F.tid & 63; F.wave = __builtin_amdgcn_readfirstlane(F.tid >> 6);
    F.G = gridDim.x; { const int bx = blockIdx.x; F.vcu = (F.G % 8 == 0) ? (bx % 8) * (F.G / 8) + bx / 8 : bx; }
    F.ws = args.ws; F.ctl = (gu32*)(args.ws + WS_CTL);
    unsigned char* ws = args.ws;
    for (int u = F.tid; u < (LDS_BYTES - LDSCTL_OFF) / 4; u += NWAVES * 64) F.LC[u] = 0;
    __syncthreads();
    if (F.tid < 23) ((LAS unsigned long long*)(F.LC + 128))[F.tid] = (unsigned long long)args.in[F.tid];
    if (F.tid == 23) ((LAS unsigned long long*)(F.LC + 128))[23] = (unsigned long long)args.out;
    __syncthreads();
#define INP(k) ((const void*)lds_ptr((LAS unsigned long long*)(F.LC + 128) + (k)))
    XcdBarrier bar; bar.bar = (unsigned*)(F.ctl + CW_BAR); bar.x = 0; bar.st = nullptr;
#if !MK_PER_PHASE
    bar = xcd_barrier_post((unsigned*)(F.ctl + CW_BAR), (volatile LAS unsigned*)F.LC);
#endif
    const int lo = args.ph_lo, hi = args.ph_hi;
#define IN(k) (lo <= (k) && (k) < hi)
#if MK_PER_PHASE
#define SEAM(k) do { } while (0)
#else
#define SEAM(k) do { if (IN(k) && IN((k) + 1)) xcd_barrier(bar); } while (0)
#endif
#define WSB (opq_p(ws))
#define HF ((float*)(WSB + WS_HF))
#define HB ((bf16*)(WSB + WS_HB))
#define AO ((bf16*)(WSB + WS_AO))
#define MIX ((bf16*)(WSB + WS_MIX))
#define Y ((bf16*)(WSB + WS_Y))
#define HD ((bf16*)(WSB + WS_HD))
#define XS ((bf16*)(WSB + WS_XS))
#define SLOT ((int*)(WSB + WS_SLOT))
#define GATE ((float*)(WSB + WS_GATE))
    const int gw_ = F.vcu * NWAVES + F.wave, NGW = F.G * NWAVES;
#define gw (opq_s(gw_))

    if (IN(0)) {
        int base = 0;
        for (int s = 0; s < 2; ++s) {
            cvt_matrix(F, (const float*)INP(4) + (size_t)s * 1024 * 3072, 1024, 3072, (bf16*)(ws + WS_SW + SW_SBIN) + (size_t)s * 3072 * 1024, MAP_ID, base);
            cvt_matrix(F, (const float*)INP(5) + (size_t)s * 1024 * 1024, 1024, 1024, (bf16*)(ws + WS_SW + SW_SBOUT) + (size_t)s * 1024 * 1024, MAP_ID, base);
        }
        cvt_matrix(F, (const float*)INP(6), 1024, 3072, (bf16*)(ws + WS_SW + SW_SCIN), MAP_ID, base);
        cvt_matrix(F, (const float*)INP(8), 1024, 1024, (bf16*)(ws + WS_SW + SW_SCOUT), MAP_ID, base);
        cvt_matrix(F, (const float*)INP(9), 1024, 704, (bf16*)(ws + WS_SW + SW_MLIN), MAP_ID, base);
        cvt_matrix(F, (const float*)INP(11), 384, 1536, (bf16*)(ws + WS_SW + SW_MLUQ), MAP_ID, base);
        cvt_matrix(F, (const float*)INP(13), 256, 2048, (bf16*)(ws + WS_SW + SW_MLUKV), MAP_UKV, base);
        cvt_matrix(F, (const float*)INP(14), 1024, 1024, (bf16*)(ws + WS_SW + SW_MLOUT), MAP_ID, base);
        { bf16* z = (bf16*)(ws + WS_SW + SW_MLIN) + (size_t)704 * 1024; for (int i = blockIdx.x * 512 + F.tid; i < 64 * 1024 / 8; i += F.G * 512) *(GAS u32x4*)(z + 8 * i) = (u32x4){0u, 0u, 0u, 0u}; }
        { const float* rw = (const float*)INP(15); bf16* rt = (bf16*)(ws + WS_SW + SW_ROUT);
          for (int i = blockIdx.x * 512 + F.tid; i < 4 * 32 * 1024; i += F.G * 512) { const int l = i >> 15, e = (i >> 10) & 31, k = i & 1023; rt[i] = (bf16)(pk2(rw[(size_t)l * 32768 + k * 32 + e], 0.f) & 0xffffu); } }
        const float* x = (const float*)INP(0);
        for (int i = blockIdx.x * 512 + F.tid; i < NTOK * DM / 8; i += F.G * 512) { const f32x4 a = *(const GAS f32x4*)(x + 8 * (size_t)i), b2 = *(const GAS f32x4*)(x + 8 * (size_t)i + 4);
            u32x4 o; o.x = pk2(a.x, a.y); o.y = pk2(a.z, a.w); o.z = pk2(b2.x, b2.y); o.w = pk2(b2.z, b2.w); *(GAS u32x4*)(HB + 8 * (size_t)i) = o; }
    }
    SEAM(0);

    for (int layer = 0; layer < 4; ++layer) {
        ws = opq_p(ws);
        const int kind = layer % 3, slot = layer / 3, P = 1 + layer * PH_PER_LAYER;
        bf16* mwbuf = (bf16*)(ws + WS_MW + (size_t)(layer & 1) * MW_BUF);
#define NXTBUF ((u8*)(opq_p(ws) + WS_MW + (size_t)((layer + 1) & 1) * MW_BUF))

        if (IN(P + 0)) {
            const bf16* Bt; int N; bf16* O;
            if (kind == 0)      { Bt = (const bf16*)(ws + WS_SW + SW_SBIN) + (size_t)slot * 3072 * 1024; N = 2048; O = (bf16*)(ws + WS_MB + MB_QK); }
            else if (kind == 1) { Bt = (const bf16*)(ws + WS_SW + SW_SCIN); N = 3072; O = (bf16*)(ws + WS_MB + MB_QK); }
            else                { Bt = (const bf16*)(ws + WS_SW + SW_MLIN); N = 768; O = (bf16*)(ws + WS_MB + MB_LAT); }
            { pg8::StaticOrder S; S.init(NTOK, N, 1024, Bt, F.G, (int)blockIdx.x); pg8::EpiBf16 E{O, N, 1.0f};
              pg8::gemm_phase<pg8::EpiBf16, pg8::StaticOrder, false>(F.lds, HB, 2048, S, E); }
            if (kind == 0) {
                const bf16* Wv = (const bf16*)(ws + WS_SW + SW_SBIN) + (size_t)slot * 3072 * 1024 + (size_t)2048 * 1024;
                pg8::StaticOrder S; S.init(1024, NTOK, 1024, HB, F.G, (int)blockIdx.x); pg8::EpiBf16 E{(bf16*)(ws + WS_MB + MB_VT), NTOK, 1.0f};
                pg8::gemm_phase<pg8::EpiBf16, pg8::StaticOrder, false>(F.lds, Wv, 2048, S, E);
            }
        }
        SEAM(P + 0);

        if (IN(P + 1)) {
            if (kind == 0) {
                const bf16* QK = (const bf16*)(ws + WS_MB + MB_QK); const bf16* Vt = (const bf16*)(ws + WS_MB + MB_VT);
                { const int cbase = __builtin_amdgcn_readfirstlane(F.LC[104]); const int k1 = (3 * NEXP * 256 - cbase + NGW - 1) / NGW; int kk = (MOE_FP8 && k1 > SB_CV) ? k1 - SB_CV : (MOE_FP8 ? 0 : k1);
                  const float* cwg = (const float*)INP(17); const float* cwu = (const float*)INP(19); const float* cwd = (const float*)INP(21);
                  cvt_moe_range(F, cwg, cwu, cwd, layer, mwbuf, 0, kk, cbase);
                  for (int u = F.vcu; u < 2 * 16 * 32; u += F.G) { const int bh = u >> 5, qb8 = u & 31; int cit = -1;
                      if (kk < k1) { cit = cbase + (gw_ & ~1) + NGW * kk; if (cit >= 3 * NEXP * 256) cit = -1; ++kk; }
                      sb_attn_block(F, QK, Vt, AO, bh >> 4, bh & 15, qb8, cit, cwg, cwu, cwd, layer, (u8*)mwbuf); }
                  __syncthreads();
                  cvt_moe_range(F, cwg, cwu, cwd, layer, mwbuf, kk, k1, cbase); }
                __syncthreads();
            } else if (kind == 1) {
                const bf16* BCH = (const bf16*)(ws + WS_MB + MB_QK); const float* cw = (const float*)INP(7);
                for (int rb = gw; rb < NTOK / 8; rb += NGW) {
                    const int r0 = rb * 8;
#pragma unroll
                    for (int jj = 0; jj < 2; ++jj) { const int c0 = 512 * jj + 8 * opq(F.lane);
                        float w0[8], w1[8], w2[8], um2[8], um1[8];
#pragma unroll
                        for (int k = 0; k < 8; ++k) { w0[k] = cw[c0 + k]; w1[k] = cw[1024 + c0 + k]; w2[k] = cw[2048 + c0 + k]; um2[k] = 0.f; um1[k] = 0.f; }
                        const bool head = (r0 % SEQ) == 0;
                        u32x4 cv[10], hv[10], bv[8];
#pragma unroll
                        for (int t = 0; t < 10; ++t) { const int row = (t < 2 && head) ? r0 : r0 + t - 2;
                            cv[t] = *(const GAS u32x4*)(BCH + (size_t)row * 3072 + 1024 + c0); hv[t] = *(const GAS u32x4*)(BCH + (size_t)row * 3072 + 2048 + c0); }
#pragma unroll
                        for (int t = 0; t < 8; ++t) bv[t] = *(const GAS u32x4*)(BCH + (size_t)(r0 + t) * 3072 + c0);
#pragma unroll
                        for (int t = 0; t < 10; ++t) { const int row = r0 + t - 2;
                            float u[8];
#pragma unroll
                            for (int k = 0; k < 4; ++k) { u[2 * k] = bf_lo(cv[t][k]) * bf_lo(hv[t][k]); u[2 * k + 1] = bf_hi(cv[t][k]) * bf_hi(hv[t][k]); }
                            if (t < 2 && head) {
#pragma unroll
                                for (int k = 0; k < 8; ++k) u[k] = 0.f; }
                            if (t >= 2) { const u32x4 bvv = bv[t - 2]; float o[8];
#pragma unroll
                                for (int k = 0; k < 4; ++k) { o[2 * k] = bf_lo(bvv[k]) * (w0[2 * k] * um2[2 * k] + w1[2 * k] * um1[2 * k] + w2[2 * k] * u[2 * k]);
                                    o[2 * k + 1] = bf_hi(bvv[k]) * (w0[2 * k + 1] * um2[2 * k + 1] + w1[2 * k + 1] * um1[2 * k + 1] + w2[2 * k + 1] * u[2 * k + 1]); }
                                u32x4 ov; ov.x = pk2(o[0], o[1]); ov.y = pk2(o[2], o[3]); ov.z = pk2(o[4], o[5]); ov.w = pk2(o[6], o[7]);
                                *(GAS u32x4*)(AO + (size_t)row * 1024 + c0) = ov; }
#pragma unroll
                            for (int k = 0; k < 8; ++k) { um2[k] = um1[k]; um1[k] = u[k]; }
                        }
                    }
                }
            } else {
                const bf16* LAT = (const bf16*)(ws + WS_MB + MB_LAT); bf16* QLN = (bf16*)(ws + WS_MB + MB_QLN); bf16* KVLN = (bf16*)(ws + WS_MB + MB_KVLN);
                bf16* KR = (bf16*)(ws + WS_MB + MB_KR); float* CS = (float*)(ws + WS_MB + MB_CS);
                const float* qn = (const float*)INP(10); const float* kvn = (const float*)INP(12); const int* posp = (const int*)INP(1);
                const int l = opq(F.lane);
                float qnw[3][2], kvw[2][2];
#pragma unroll
                for (int jx = 0; jx < 3; ++jx) { qnw[jx][0] = qn[128 * jx + 2 * l]; qnw[jx][1] = qn[128 * jx + 2 * l + 1]; }
#pragma unroll
                for (int jx = 0; jx < 2; ++jx) { kvw[jx][0] = kvn[128 * jx + 2 * l]; kvw[jx][1] = kvn[128 * jx + 2 * l + 1]; }
                for (int rowa = gw; rowa < NTOK; rowa += 8 * NGW) {
                    unsigned vv[8][6]; int pq[8];
#pragma unroll
                    for (int q = 0; q < 8; ++q) { const int rowq = (rowa + q * NGW < NTOK) ? rowa + q * NGW : rowa; const unsigned* lrq = (const unsigned*)(LAT + (size_t)rowq * 768);
#pragma unroll
                        for (int jx = 0; jx < 6; ++jx) vv[q][jx] = lrq[64 * jx + l];
                        pq[q] = posp[rowq]; }
#pragma unroll
                    for (int q = 0; q < 8; ++q) { const int row = rowa + q * NGW; if (row >= NTOK) continue;
                    unsigned v[6];
#pragma unroll
                    for (int jx = 0; jx < 6; ++jx) v[jx] = vv[q][jx];
                    float sq = 0.f, skv = 0.f;
#pragma unroll
                    for (int jx = 0; jx < 3; ++jx) { const float a = bf_lo(v[jx]), b2 = bf_hi(v[jx]); sq += a * a + b2 * b2; }
#pragma unroll
                    for (int jx = 3; jx < 5; ++jx) { const float a = bf_lo(v[jx]), b2 = bf_hi(v[jx]); skv += a * a + b2 * b2; }
                    const float rq = __builtin_amdgcn_rsqf(wave_sum(sq) * (1.0f / 384.0f) + RMS_EPS), rkv = __builtin_amdgcn_rsqf(wave_sum(skv) * (1.0f / 256.0f) + RMS_EPS);
#pragma unroll
                    for (int jx = 0; jx < 3; ++jx) { const int c = 128 * jx + 2 * l; ((unsigned*)(QLN + (size_t)row * 384))[64 * jx + l] = pk2(bf_lo(v[jx]) * rq * qnw[jx][0], bf_hi(v[jx]) * rq * qnw[jx][1]); }
#pragma unroll
                    for (int jx = 3; jx < 5; ++jx) { const int c = 128 * (jx - 3) + 2 * l; ((unsigned*)(KVLN + (size_t)row * 256))[64 * (jx - 3) + l] = pk2(bf_lo(v[jx]) * rkv * kvw[jx - 3][0], bf_hi(v[jx]) * rkv * kvw[jx - 3][1]); }
                    const float pos = (float)pq[q];
                    const int fi = 2 * (l & 15);
                    float cs0, sn0, cs1, sn1;
                    { const double invf0 = (double)(float)exp2(-(double)fi * (13.287712379549449 / 32.0)), invf1 = (double)(float)exp2(-(double)(fi + 1) * (13.287712379549449 / 32.0));
                      const double r0 = (double)pos * invf0 * 0.15915494309189535, r1 = (double)pos * invf1 * 0.15915494309189535;
                      const float f0 = (float)(r0 - rint(r0)), f1 = (float)(r1 - rint(r1));
                      cs0 = __builtin_amdgcn_cosf(f0); sn0 = __builtin_amdgcn_sinf(f0); cs1 = __builtin_amdgcn_cosf(f1); sn1 = __builtin_amdgcn_sinf(f1); }
                    const unsigned mine = v[5], other = __shfl_xor(mine, 16);
                    const float mx = bf_lo(mine), my = bf_hi(mine), ox = bf_lo(other), oy = bf_hi(other);
                    if (l < 32) {
                        float rx, ry;
                        if (l < 16) { rx = mx * cs0 - ox * sn0; ry = my * cs1 - oy * sn1; }
                        else        { rx = mx * cs0 + ox * sn0; ry = my * cs1 + oy * sn1; }
                        ((unsigned*)(KR + (size_t)row * 64))[l] = pk2(rx, ry);
                        if (l < 16) { float* c = CS + (size_t)row * 64; c[fi] = cs0; c[fi + 1] = cs1; c[32 + fi] = sn0; c[32 + fi + 1] = sn1; }
                    }
                    }
                }
            }
        }
        SEAM(P + 1);

        if (kind == 2) {
            if (IN(P + 2)) {
                const bf16* QLN = (const bf16*)(ws + WS_MB + MB_QLN); const bf16* KVLN = (const bf16*)(ws + WS_MB + MB_KVLN);
                const bf16* Wuq = (const bf16*)(ws + WS_SW + SW_MLUQ); const bf16* Wk = (const bf16*)(ws + WS_SW + SW_MLUKV); const bf16* Wv = Wk + (size_t)1024 * 256;
                for (int gi = 0; gi < 3; ++gi) {
                    const bf16* A = gi == 0 ? QLN : gi == 1 ? KVLN : Wv; const bf16* Bt = gi == 0 ? Wuq : gi == 1 ? Wk : KVLN;
                    const int M = gi == 2 ? 1024 : NTOK, N = gi == 0 ? 1536 : gi == 1 ? 1024 : NTOK, K = gi == 0 ? 384 : 256;
                    bf16* O = (bf16*)(ws + WS_MB + (gi == 0 ? MB_Q : gi == 1 ? MB_KN : MB_MVT));
                    pg8::StaticOrder S; S.init(M, N, K, Bt, F.G, (int)blockIdx.x); pg8::EpiBf16 E{O, N, 1.0f};
                    pg8::gemm_phase<pg8::EpiBf16, pg8::StaticOrder, false>(F.lds, A, 2 * K, S, E);
                }
            }
            SEAM(P + 2);
            if (IN(P + 3)) {
                const bf16* Q = (const bf16*)(ws + WS_MB + MB_Q); const bf16* Kn = (const bf16*)(ws + WS_MB + MB_KN); const bf16* KR = (const bf16*)(ws + WS_MB + MB_KR);
                const bf16* Vt = (const bf16*)(ws + WS_MB + MB_MVT); const float* CS = (const float*)(ws + WS_MB + MB_CS);
                for (int p = (int)blockIdx.x; p < 256; p += F.G) { const int bh = p >> 4, xq = p & 15;
                    mla_attn_unit(F, Q, Kn, KR, Vt, CS, AO, bh >> 3, bh & 7, 31 - xq);
                    mla_attn_unit(F, Q, Kn, KR, Vt, CS, AO, bh >> 3, bh & 7, xq); }
                __syncthreads();
            }
            SEAM(P + 3);
        }

        if (IN(P + 4)) {
            const bf16* Bt = kind == 0 ? (const bf16*)(ws + WS_SW + SW_SBOUT) + (size_t)slot * 1024 * 1024 : kind == 1 ? (const bf16*)(ws + WS_SW + SW_SCOUT) : (const bf16*)(ws + WS_SW + SW_MLOUT);
            pg8::StaticOrder S; S.init(NTOK, 1024, 1024, Bt, F.G, (int)blockIdx.x); pg8::EpiBf16 E{MIX, 1024, 1.0f};
            pg8::gemm_phase<pg8::EpiBf16, pg8::StaticOrder, false>(F.lds, AO, 2048, S, E);
        }
        SEAM(P + 4);

        if (IN(P + 5)) {
            const float* g1 = (const float*)INP(2) + (size_t)(layer * 2 + 0) * 1024; const float* b1 = (const float*)INP(3) + (size_t)(layer * 2 + 0) * 1024;
            const bf16* Rt = (const bf16*)(ws + WS_SW + SW_ROUT) + (size_t)layer * 32 * 1024; const float* rb = (const float*)INP(16) + layer * 32;
            gu32* CNT = F.ctl + CW_CNT + layer * 2048;
            const bf16* hin = HB; bf16* H1p = (bf16*)HF; const bf16* MIXp = MIX; unsigned long long* SGp = (unsigned long long*)SLOT; bf16* XSp = XS;
            LAS unsigned char* rows = F.lds;
            LAS float* lg = (LAS float*)(F.lds + 132096);
            LAS int* dstt = (LAS int*)(F.lds + 140544);
            LAS int* bases = (LAS int*)(F.lds + 141568);
            const int lane = opq(F.lane), fr = lane & 15, fq = lane >> 4, w = F.wave;
            f32x4 lnG[4], lnB[4];
#pragma unroll
            for (int jx = 0; jx < 4; ++jx) { lnG[jx] = *(const GAS f32x4*)(g1 + 4 * lane + 256 * jx); lnB[jx] = *(const GAS f32x4*)(b1 + 4 * lane + 256 * jx); }
            for (int blk = F.vcu; blk < NTOK / 64; blk += F.G) {
                u32x2 rh[8][4], rm[8][4];
#pragma unroll
                for (int r = 0; r < 8; ++r)
#pragma unroll
                    for (int jx = 0; jx < 4; ++jx) { const size_t o = ((size_t)blk * 64 + 8 * w + r) * 1024 + 4 * lane + 256 * jx; rh[r][jx] = *(const GAS u32x2*)(hin + o); rm[r][jx] = *(const GAS u32x2*)(MIXp + o); }
#pragma unroll
                for (int rp = 0; rp < 4; ++rp) { const int lr0 = 8 * w + 2 * rp; const size_t row = (size_t)blk * 64 + lr0;
                    f32x4 va[4], vc[4];
#pragma unroll
                    for (int jx = 0; jx < 4; ++jx) { const u32x2 ha = rh[2 * rp][jx], hc = rh[2 * rp + 1][jx], ma = rm[2 * rp][jx], mc = rm[2 * rp + 1][jx];
                        va[jx] = (f32x4){bf_lo(ha.x), bf_hi(ha.x), bf_lo(ha.y), bf_hi(ha.y)} * DN_ALPHA + (f32x4){bf_lo(ma.x), bf_hi(ma.x), bf_lo(ma.y), bf_hi(ma.y)};
                        vc[jx] = (f32x4){bf_lo(hc.x), bf_hi(hc.x), bf_lo(hc.y), bf_hi(hc.y)} * DN_ALPHA + (f32x4){bf_lo(mc.x), bf_hi(mc.x), bf_lo(mc.y), bf_hi(mc.y)}; }
                    ln_pair_finish(va, vc, lnG, lnB);
#pragma unroll
                    for (int jx = 0; jx < 4; ++jx) { const size_t o = row * 1024 + 4 * lane + 256 * jx;
                        const u32x2 pa = {pk2(va[jx].x, va[jx].y), pk2(va[jx].z, va[jx].w)}, pc = {pk2(vc[jx].x, vc[jx].y), pk2(vc[jx].z, vc[jx].w)};
                        *(GAS u32x2*)(H1p + o) = pa; *(GAS u32x2*)(H1p + o + 1024) = pc;
                        *(LAS u32x2*)(rows + lr0 * 2064 + (4 * lane + 256 * jx) * 2) = pa; *(LAS u32x2*)(rows + (lr0 + 1) * 2064 + (4 * lane + 256 * jx) * 2) = pc; }
                }
                const int tt = w >> 1, et = w & 1;
                bf16x8 wv[32];
                { const bf16* wp = Rt + (size_t)(16 * et + fr) * 1024 + 8 * fq;
#pragma unroll
                  for (int s2 = 0; s2 < 32; ++s2) wv[s2] = *(const GAS bf16x8*)(wp + 32 * s2); }
                const f32x4 rbv = *(const GAS f32x4*)(rb + 16 * et + 4 * fq);
                __syncthreads();
                { f32x4 a0 = {0.f, 0.f, 0.f, 0.f}; const LAS unsigned char* hp = rows + (16 * tt + fr) * 2064 + 16 * fq;
#pragma unroll
                  for (int s2 = 0; s2 < 32; ++s2) { const bf16x8 hfr = *(const LAS bf16x8*)(hp + 64 * s2); a0 = __builtin_amdgcn_mfma_f32_16x16x32_bf16(wv[s2], hfr, a0, 0, 0, 0); }
#pragma unroll
                  for (int vv = 0; vv < 4; ++vv) lg[(16 * tt + fr) * 33 + 16 * et + 4 * fq + vv] = a0[vv] + rbv[vv]; }
                __syncthreads();
                if (w == 0) {
                    float lv[32];
#pragma unroll
                    for (int e = 0; e < 32; ++e) lv[e] = lg[lane * 33 + e];
                    int ce[4]; float cv[4];
#pragma unroll
                    for (int k = 0; k < 4; ++k) { float best = -3.0e38f; int bi = 0;
#pragma unroll
                        for (int e = 0; e < 32; ++e) { bool taken = false;
#pragma unroll
                            for (int q = 0; q < k; ++q) taken = taken || (ce[q] == e);
                            if (!taken && lv[e] > best) { best = lv[e]; bi = e; } }
                        ce[k] = bi; cv[k] = best; }
                    float ex[4], es = 0.f;
#pragma unroll
                    for (int k = 0; k < 4; ++k) { ex[k] = __builtin_amdgcn_exp2f((cv[k] - cv[0]) * 1.4426950408889634f); es += ex[k]; }
                    const float ies = __builtin_amdgcn_rcpf(es); const int token = blk * 64 + lane;
                    int rank[4] = {0, 0, 0, 0}; int mycnt = 0; const unsigned long long below = (1ull << lane) - 1ull;
#pragma unroll 1
                    for (int e = 0; e < 32; ++e) { const bool has = (ce[0] == e) | (ce[1] == e) | (ce[2] == e) | (ce[3] == e); const unsigned long long mask = __ballot(has);
                        const int nb = __popcll(mask & below);
#pragma unroll
                        for (int k = 0; k < 4; ++k) rank[k] = (ce[k] == e) ? nb : rank[k];
                        mycnt = (lane == e) ? __popcll(mask) : mycnt; }
                    if (lane < 32) bases[lane] = (int)__hip_atomic_fetch_add(CNT + lane * 64, (unsigned)mycnt, RLX_AGENT);
                    LDS_WAIT();
#pragma unroll
                    for (int k = 0; k < 4; ++k) { const int pos = bases[ce[k]] + rank[k]; const int sl = token * 4 + k; SGp[ce[k] * ECAP + pos] = (unsigned long long)(unsigned)sl | ((unsigned long long)__builtin_bit_cast(unsigned, ex[k] * ies) << 32); dstt[lane * 4 + k] = ce[k] * ECAP + pos; }
                }
                __syncthreads();
                for (int r = 0; r < 8; ++r) {
                    if constexpr (MOE_FP8) {
                        const u32x4 p0 = *(const LAS u32x4*)(rows + (8 * w + r) * 2064 + 32 * lane), p1 = *(const LAS u32x4*)(rows + (8 * w + r) * 2064 + 32 * lane + 16);
                        u32x4 q; q.x = pk4_fp8(bf_lo(p0.x), bf_hi(p0.x), bf_lo(p0.y), bf_hi(p0.y)); q.y = pk4_fp8(bf_lo(p0.z), bf_hi(p0.z), bf_lo(p0.w), bf_hi(p0.w));
                        q.z = pk4_fp8(bf_lo(p1.x), bf_hi(p1.x), bf_lo(p1.y), bf_hi(p1.y)); q.w = pk4_fp8(bf_lo(p1.z), bf_hi(p1.z), bf_lo(p1.w), bf_hi(p1.w));
                        *(GAS u32x4*)((u8*)XSp + (size_t)(blk * 64 + 8 * w + r) * 1024 + 16 * lane) = q;
                    } else {
#pragma unroll
                    for (int k = 0; k < 4; ++k) { const size_t d = (size_t)dstt[(8 * w + r) * 4 + k];
#pragma unroll
                        for (int hh = 0; hh < 2; ++hh) { const int ch = lane + 64 * hh; const u32x4 val = *(const LAS u32x4*)(rows + (8 * w + r) * 2064 + 16 * ch); *(GAS u32x4*)(XSp + d * 1024 + 8 * ch) = val; } }
                    }
                }
                __syncthreads();
            }
            __syncthreads();
            if (kind != 0) cvt_moe_layer(F, (const float*)INP(17), (const float*)INP(19), (const float*)INP(21), layer, mwbuf, F.LC[104]);
            __syncthreads();
        }
        SEAM(P + 5);

        if (IN(P + 6) || IN(P + 7)) {
            if (F.wave == 0) {
                const int t_ = opq(F.lane), el = t_ & 31;
                const int c = (int)__hip_atomic_load(F.ctl + CW_CNT + layer * 2048 + el * 64, RLX_AGENT);
                const int tl = (c + 255) >> 8; int inc = tl;
#pragma unroll
                for (int o = 1; o < 32; o <<= 1) { const int v = __shfl_up(inc, o, 32); if (el >= o) inc += v; }
                if (t_ < 32) { F.LC[64 + t_] = c; F.LC[16 + t_] = inc - tl; }
                if (t_ < 32) { for (int k = 0; k < tl; ++k) F.LC[192 + inc - tl + k] = t_; }
                if (t_ == 31) { const int acc = inc; F.LC[16 + 32] = acc;
                    const bool tc = MOE_FP8 && layer < 3; const int r6 = (8 * acc) % F.G, r7 = (4 * acc) % F.G, i6 = (tc && r6) ? F.G - r6 : 0, i7 = (tc && r7) ? F.G - r7 : 0;
                    F.LC[100] = r6; F.LC[101] = i6; F.LC[102] = r7; F.LC[103] = i7; F.LC[104] = (i6 + i7) * NWAVES * CVT_QUOTA; }
            }
            __syncthreads();
        }
        if (IN(P + 6)) {
            { pg8::MoeOrderT<MOE_FP8 != 0> S{F.LC + 16, F.LC + 64, 8, F.G, F.vcu, 1024 * MOE_EB, 0, (const u8*)mwbuf, (size_t)2048 * 1024 * MOE_EB, (const unsigned long long*)SLOT};
            pg8::EpiSwiGLU E{HD, (const float*)INP(18) + (size_t)layer * 32 * 1024, (const float*)INP(20) + (size_t)layer * 32 * 1024};
            pg8::gemm_phase<pg8::EpiSwiGLU, pg8::MoeOrderT<MOE_FP8 != 0>, MOE_FP8 != 0>(F.lds, XS, 1024 * MOE_EB, S, E); }
            { const int r6 = __builtin_amdgcn_readfirstlane(F.LC[100]), i6 = __builtin_amdgcn_readfirstlane(F.LC[101]);
              if (i6 > 0 && F.vcu >= r6) cvt_moe_stream(F, (const float*)INP(17), (const float*)INP(19), (const float*)INP(21), layer + 1, NXTBUF, (F.vcu - r6) * NWAVES + F.wave, i6 * NWAVES, CVT_QUOTA); }
        }
        SEAM(P + 6);
        if (IN(P + 7)) {
            { pg8::MoeOrderT<false> S{F.LC + 16, F.LC + 64, 4, F.G, F.vcu, 1024 * MOE_EB, 1, (const u8*)mwbuf + MW_DN, (size_t)1024 * 1024 * MOE_EB, (const unsigned long long*)SLOT};
            pg8::EpiDown E{(u8*)Y, (const float*)INP(22) + (size_t)layer * 32 * 1024, (const unsigned long long*)SLOT};
            pg8::gemm_phase<pg8::EpiDown, pg8::MoeOrderT<false>, MOE_FP8 != 0>(F.lds, HD, 1024 * MOE_EB, S, E); }
            { const int r7 = __builtin_amdgcn_readfirstlane(F.LC[102]), i7 = __builtin_amdgcn_readfirstlane(F.LC[103]), i6 = __builtin_amdgcn_readfirstlane(F.LC[101]);
              if (i7 > 0 && F.vcu >= r7) cvt_moe_stream(F, (const float*)INP(17), (const float*)INP(19), (const float*)INP(21), layer + 1, NXTBUF, i6 * NWAVES * CVT_QUOTA + (F.vcu - r7) * NWAVES + F.wave, i7 * NWAVES, CVT_QUOTA); }
        }
        SEAM(P + 7);
        if (IN(P + 8)) {
            const float* g2 = (const float*)INP(2) + (size_t)(layer * 2 + 1) * 1024; const float* b2 = (const float*)INP(3) + (size_t)(layer * 2 + 1) * 1024;
            const int lane = opq(F.lane); const bf16* H1p = (const bf16*)HF; float* hout = (float*)INP(23); const bool lastl = layer == 3; const u8* Yp = (const u8*)Y; bf16* HBp = HB;
            f32x4 lnG2[4], lnB2[4];
#pragma unroll
            for (int jx = 0; jx < 4; ++jx) { lnG2[jx] = *(const GAS f32x4*)(g2 + 4 * lane + 256 * jx); lnB2[jx] = *(const GAS f32x4*)(b2 + 4 * lane + 256 * jx); }
            for (int row0 = gw; row0 < NTOK; row0 += 4 * NGW) {
                int ya_[2][4][4], yc_[2][4][4]; u32x2 ha_[2][4], hc_[2][4]; int rws[2], rws2[2]; bool has[2], two_[2];
#pragma unroll
                for (int pr = 0; pr < 2; ++pr) { const int row = row0 + 2 * pr * NGW; has[pr] = row < NTOK; const int rowc = has[pr] ? row : gw; two_[pr] = has[pr] && (row + NGW < NTOK); const int row2 = two_[pr] ? row + NGW : rowc;
                    rws[pr] = rowc; rws2[pr] = row2;
#pragma unroll
                    for (int jx = 0; jx < 4; ++jx) { ha_[pr][jx] = *(const GAS u32x2*)(H1p + (size_t)rowc * 1024 + 4 * lane + 256 * jx); hc_[pr][jx] = *(const GAS u32x2*)(H1p + (size_t)row2 * 1024 + 4 * lane + 256 * jx);
#pragma unroll
                        for (int k = 0; k < 4; ++k) { ya_[pr][jx][k] = *(const GAS int*)(Yp + ((size_t)rowc * 4 + k) * 1024 + 4 * lane + 256 * jx); yc_[pr][jx][k] = *(const GAS int*)(Yp + ((size_t)row2 * 4 + k) * 1024 + 4 * lane + 256 * jx); } } }
#pragma unroll
                for (int pr = 0; pr < 2; ++pr) { if (!has[pr]) continue; const int row = rws[pr], row2 = rws2[pr]; const bool two = two_[pr];
                f32x4 va[4], vc[4];
#pragma unroll
                for (int jx = 0; jx < 4; ++jx) { const f32x4 ha = {bf_lo(ha_[pr][jx].x), bf_hi(ha_[pr][jx].x), bf_lo(ha_[pr][jx].y), bf_hi(ha_[pr][jx].y)}, hc = {bf_lo(hc_[pr][jx].x), bf_hi(hc_[pr][jx].x), bf_lo(hc_[pr][jx].y), bf_hi(hc_[pr][jx].y)};
                    f32x4 sa = {0.f, 0.f, 0.f, 0.f}, sc = {0.f, 0.f, 0.f, 0.f};
#pragma unroll
                    for (int k = 0; k < 4; ++k) { const int ya = ya_[pr][jx][k], yc = yc_[pr][jx][k];
                        const f32x2 a0 = __builtin_amdgcn_cvt_pk_f32_fp8(ya, false), a1 = __builtin_amdgcn_cvt_pk_f32_fp8(ya, true), c0 = __builtin_amdgcn_cvt_pk_f32_fp8(yc, false), c1 = __builtin_amdgcn_cvt_pk_f32_fp8(yc, true);
                        sa += (f32x4){a0.x, a0.y, a1.x, a1.y}; sc += (f32x4){c0.x, c0.y, c1.x, c1.y}; }
                    va[jx] = ha * DN_ALPHA + sa * 0.0625f; vc[jx] = hc * DN_ALPHA + sc * 0.0625f; }
                ln_pair_finish(va, vc, lnG2, lnB2);
#pragma unroll
                for (int jx = 0; jx < 4; ++jx) {
                    if (lastl) { *(GAS f32x4*)(hout + (size_t)row * 1024 + 4 * lane + 256 * jx) = va[jx]; if (two) *(GAS f32x4*)(hout + (size_t)row2 * 1024 + 4 * lane + 256 * jx) = vc[jx]; }
                    else { *(GAS u32x2*)(HBp + (size_t)row * 1024 + 4 * lane + 256 * jx) = (u32x2){pk2(va[jx].x, va[jx].y), pk2(va[jx].z, va[jx].w)};
                        if (two) *(GAS u32x2*)(HBp + (size_t)row2 * 1024 + 4 * lane + 256 * jx) = (u32x2){pk2(vc[jx].x, vc[jx].y), pk2(vc[jx].z, vc[jx].w)}; } }
                }
            }
        }
        SEAM(P + 8);
    }
#undef IN
#undef SEAM
#undef NXTBUF
#undef gw
#undef WSB
#undef HF
#undef HB
#undef AO
#undef MIX
#undef Y
#undef HD
#undef XS
#undef SLOT
#undef GATE
}

extern "C" void kernel_launch(void* const* d_in, const int* in_sizes, int n_in, void* d_out, int out_size, void* d_ws, size_t ws_size, hipStream_t stream) {
    static int grid = 0;
    if (grid == 0) {
        if (n_in != 23 || out_size != NTOK * DM || ws_size < WS_END) { fprintf(stderr, "kernel_launch: unexpected shapes (n_in %d out %d ws %zu, need %zu)\n", n_in, out_size, ws_size, (size_t)WS_END); grid = -1; return; }
        int dev = 0, cus = 0, per_cu = 0;
        if (hipGetDevice(&dev) != hipSuccess || hipDeviceGetAttribute(&cus, hipDeviceAttributeMultiprocessorCount, dev) != hipSuccess) { grid = -1; return; }
        if (hipFuncSetAttribute((const void*)mk_fwd, hipFuncAttributeMaxDynamicSharedMemorySize, LDS_BYTES) != hipSuccess) { fprintf(stderr, "kernel_launch: hipFuncSetAttribute failed\n"); grid = -1; return; }
        if (hipOccupancyMaxActiveBlocksPerMultiprocessor(&per_cu, (const void*)mk_fwd, NWAVES * 64, LDS_BYTES) != hipSuccess || per_cu < 1) { fprintf(stderr, "kernel_launch: occupancy query says %d\n", per_cu); }
        (void)hipGetLastError();
        grid = cus;
    }
    if (grid < 0) return;
    if (hipMemsetAsync((char*)d_ws + WS_CTL, 0, CTL_ZERO_BYTES, stream) != hipSuccess) return;
    Args a{};
    for (int i = 0; i < 23; ++i) a.in[i] = d_in[i];
    a.out = (float*)d_out; a.ws = (unsigned char*)d_ws;
#if MK_PER_PHASE
    for (int p = 0; p < N_PHASES; ++p) {
        const int layer = (p - 1) / PH_PER_LAYER, q = (p - 1) % PH_PER_LAYER;
        if (p > 0 && (layer % 3) != 2 && (q == 2 || q == 3)) continue;
        a.ph_lo = p; a.ph_hi = p + 1;
        hipLaunchKernelGGL(mk_fwd, dim3(grid), dim3(NWAVES * 64), LDS_BYTES, stream, a);
    }
#else
    a.ph_lo = 0; a.ph_hi = N_PHASES;
    hipLaunchKernelGGL(mk_fwd, dim3(grid), dim3(NWAVES * 64), LDS_BYTES, stream, a);
#endif
}
```

```cpp
#include <hip/hip_runtime.h>
#include <cstdio>
#include <cstdint>

#ifndef MK_PER_PHASE
#define MK_PER_PHASE 0
#endif

#ifndef G3_EARLY
#define G3_EARLY true
#endif
#ifndef G4_EARLY
#define G4_EARLY true
#endif
#ifndef MOE_FP8
#define MOE_FP8 1
#endif
#define GAS __attribute__((address_space(1)))
#define LAS __attribute__((address_space(3)))
typedef unsigned short bf16;
typedef short bf16x8 __attribute__((ext_vector_type(8)));
typedef short s16x4 __attribute__((ext_vector_type(4)));
typedef float f32x4 __attribute__((ext_vector_type(4)));
typedef float f32x2 __attribute__((ext_vector_type(2)));
typedef float f32x16 __attribute__((ext_vector_type(16)));
typedef unsigned u32x4 __attribute__((ext_vector_type(4)));
typedef unsigned u32x2 __attribute__((ext_vector_type(2)));
typedef __bf16 bf16x2_t __attribute__((ext_vector_type(2)));
typedef GAS unsigned gu32;
typedef int i32x4 __attribute__((ext_vector_type(4)));
typedef int i32x8 __attribute__((ext_vector_type(8)));
typedef unsigned char u8;
constexpr int MOE_EB = MOE_FP8 ? 1 : 2;


#define RLX_AGENT __ATOMIC_RELAXED, __HIP_MEMORY_SCOPE_AGENT
#define LDS_WAIT() asm volatile("s_waitcnt lgkmcnt(0)" ::: "memory")
#define VM_WAIT() asm volatile("s_waitcnt vmcnt(0)" ::: "memory")
#define DI __device__ __forceinline__
DI unsigned pk4_fp8(float a, float b, float c, float d) { int w = 0; w = __builtin_amdgcn_cvt_pk_fp8_f32(a, b, w, false); w = __builtin_amdgcn_cvt_pk_fp8_f32(c, d, w, true); return (unsigned)w; }

DI int opq(int v) { asm volatile("" : "+v"(v)); return v; }
DI int opq_s(int v) { asm volatile("" : "+s"(v)); return v; }
template <class T> DI T* opq_p(T* p) { asm volatile("" : "+s"(p)); return p; }
DI unsigned pk2(float lo, float hi) { f32x2 v = {lo, hi}; bf16x2_t b = __builtin_convertvector(v, bf16x2_t); return __builtin_bit_cast(unsigned, b); }
DI float fp8_dec(unsigned w, int byte) { const unsigned b = (w >> (8 * byte)) & 0xffu; const float mag = __builtin_bit_cast(float, (b & 0x7fu) << 20) * 0x1p120f; return (b & 0x80u) ? -mag : mag; }
DI float bf_lo(unsigned u) { return __builtin_bit_cast(float, u << 16); }
DI float bf_hi(unsigned u) { return __builtin_bit_cast(float, u & 0xffff0000u); }
DI unsigned long long lds_ptr(LAS unsigned long long* p) { asm volatile("" ::: "memory"); const unsigned long long v = *p; const unsigned lo = __builtin_amdgcn_readfirstlane((unsigned)v), hi = __builtin_amdgcn_readfirstlane((unsigned)(v >> 32)); return ((unsigned long long)hi << 32) | lo; }
template <int CTRL> DI float dpp_f(float v) { return __builtin_bit_cast(float, __builtin_amdgcn_update_dpp(0, __builtin_bit_cast(int, v), CTRL, 0xF, 0xF, true)); }
DI float wave_sum(float v) {
    v += dpp_f<0xB1>(v);
    v += dpp_f<0x4E>(v);
    v += dpp_f<0x141>(v);
    v += dpp_f<0x140>(v);
    const int vi = __builtin_bit_cast(int, v);
    return (__builtin_bit_cast(float, __builtin_amdgcn_readlane(vi, 0)) + __builtin_bit_cast(float, __builtin_amdgcn_readlane(vi, 16))) + (__builtin_bit_cast(float, __builtin_amdgcn_readlane(vi, 32)) + __builtin_bit_cast(float, __builtin_amdgcn_readlane(vi, 48)));
}

constexpr int NTOK = 16384, DM = 1024, SEQ = 8192, NEXP = 32, TOPK = 4, ECAP = 16384;
constexpr float DN_ALPHA = 1.681792830507429f;
constexpr float LN_EPS = 1e-5f, RMS_EPS = 1e-6f;
constexpr int NWAVES = 8;

constexpr size_t MiB = 1u << 20;
constexpr size_t WS_CTL = 0, CTL_ZERO_BYTES = 1 * MiB;
constexpr size_t WS_SW = 2 * MiB;
constexpr size_t SW_SBIN = 0;
constexpr size_t SW_SBOUT = 12 * MiB;
constexpr size_t SW_SCIN = 16 * MiB;
constexpr size_t SW_SCOUT = 22 * MiB;
constexpr size_t SW_MLIN = 24 * MiB;
constexpr size_t SW_MLUQ = 26 * MiB;
constexpr size_t SW_MLUKV = 28 * MiB;
constexpr size_t SW_MLOUT = 29 * MiB;
constexpr size_t SW_ROUT = 31 * MiB;
constexpr size_t WS_HF = 34 * MiB;
constexpr size_t WS_HB = 98 * MiB;
constexpr size_t WS_MB = 130 * MiB;
constexpr size_t MB_QK = 0;
constexpr size_t MB_VT = 64 * MiB;
constexpr size_t MB_LAT = 0;
constexpr size_t MB_QLN = 24 * MiB;
constexpr size_t MB_KVLN = 36 * MiB;
constexpr size_t MB_KR = 44 * MiB;
constexpr size_t MB_CS = 46 * MiB;
constexpr size_t MB_Q = 50 * MiB;
constexpr size_t MB_KN = 98 * MiB;
constexpr size_t MB_MVT = 130 * MiB;
constexpr size_t WS_HD = 130 * MiB;
constexpr size_t WS_AO = 306 * MiB;
constexpr size_t WS_MIX = 338 * MiB;
constexpr size_t WS_Y = 370 * MiB;
constexpr size_t WS_SLOT = 498 * MiB;
constexpr size_t WS_GATE = 500 * MiB;
constexpr size_t WS_MW = 502 * MiB;
constexpr size_t MW_BUF = 192 * MiB, MW_DN = 128 * MiB;
constexpr size_t WS_XS = 886 * MiB;
constexpr size_t WS_END = 1910 * MiB;

constexpr int CW_TMO = 0;
constexpr int CW_BAR = 4096;
constexpr int CW_CNT = 8192;

constexpr int RING_BYTES = 131072;
constexpr int LDSCTL_OFF = 143360;
constexpr int LDS_BYTES = 147456;

#define XB_TMO      128
#define XB_XCNT(j)  (256  + 64 * (j))
#define XB_XSUB(j)  (1280 + 64 * (j))
#define XB_XGEN(j)  (2304 + 64 * (j))
#define XB_TOP      3328
#define XB_TOPGEN   3392
#define XCD_BAR_WORDS 3456
#define XB_SPIN_CAP (1u << 18)

DI unsigned xb_ld(unsigned* p)              { return __hip_atomic_load(p, __ATOMIC_RELAXED, __HIP_MEMORY_SCOPE_AGENT); }
DI unsigned xb_add(unsigned* p, unsigned v) { return __hip_atomic_fetch_add(p, v, __ATOMIC_RELAXED, __HIP_MEMORY_SCOPE_AGENT); }
DI unsigned xb_xcc_id() { return (unsigned)__builtin_amdgcn_s_getreg((3 << 11) | 20) & 0xFu; }
#define XB_SPIN(cond, bar) do { unsigned _sp = 0; while (cond) { __builtin_amdgcn_s_sleep(1); \
    if ((++_sp & 255u) == 0u) { if (xb_ld(&(bar)[XB_TMO])) break; if (_sp > XB_SPIN_CAP) { atomicAdd(&(bar)[XB_TMO], 1u); break; } } } } while (0)

struct XcdBarrier { unsigned* bar; unsigned x; volatile LAS unsigned* st; };

DI XcdBarrier xcd_barrier_post(unsigned* bar, volatile LAS unsigned* st) {
    XcdBarrier b; b.bar = bar; b.x = xb_xcc_id(); b.st = st;
    if (threadIdx.x == 0) (void)xb_add(&bar[XB_XCNT(b.x)], 1u);
    return b;
}
DI void xcd_barrier_complete(unsigned* bar, unsigned x, unsigned& nloc, unsigned& nx) {
    const unsigned G = gridDim.x * gridDim.y * gridDim.z;
    unsigned sum, cnt, mine, sp = 0u;
    for (;;) {
        sum = 0u; cnt = 0u; mine = 0u;
#pragma unroll
        for (unsigned j = 0; j < 16; ++j) { const unsigned c = xb_ld(&bar[XB_XCNT(j)]); sum += c; cnt += (c > 0u) ? 1u : 0u; mine = (j == x) ? c : mine; }
        if (sum == G) break;
        __builtin_amdgcn_s_sleep(1);
        if ((++sp & 255u) == 0u) { if (xb_ld(&bar[XB_TMO])) break; if (sp > XB_SPIN_CAP) { atomicAdd(&bar[XB_TMO], 1u); break; } }
    }
    nloc = mine > 0u ? mine : 1u; nx = cnt > 0u ? cnt : 1u;
}
DI void xcd_barrier(const XcdBarrier& b) {
    asm volatile("s_waitcnt vmcnt(0)" ::: "memory");
    __syncthreads();
    if (threadIdx.x == 0) {
        unsigned* bar = b.bar; unsigned bx_ = b.x;
        asm volatile("" : "+s"(bar), "+s"(bx_));
        __builtin_amdgcn_s_waitcnt(0);
        unsigned nloc = b.st[0], nx = b.st[1];
        if (nloc == 0u) { xcd_barrier_complete(bar, bx_, nloc, nx); b.st[0] = nloc; b.st[1] = nx; }
        const unsigned old = xb_add(&bar[XB_XSUB(bx_)], 1u);
        const unsigned gen = old / nloc;
        if (old + 1u == (gen + 1u) * nloc) {
            __builtin_amdgcn_fence(__ATOMIC_RELEASE, "agent");
            asm volatile("s_waitcnt vmcnt(0)" ::: "memory");
            const unsigned og = xb_add(&bar[XB_TOP], 1u);
            const unsigned tg = og / nx;
            if (og + 1u == (tg + 1u) * nx) xb_add(&bar[XB_TOPGEN], 1u);
            else XB_SPIN(xb_ld(&bar[XB_TOPGEN]) == tg, bar);
            __builtin_amdgcn_fence(__ATOMIC_ACQUIRE, "agent");
            xb_add(&bar[XB_XGEN(bx_)], 1u);
            asm volatile("s_waitcnt vmcnt(0)" ::: "memory");
        } else {
            XB_SPIN(xb_ld(&bar[XB_XGEN(bx_)]) == gen, bar);
            __builtin_amdgcn_fence(__ATOMIC_ACQUIRE, "agent");
            asm volatile("s_waitcnt vmcnt(0)" ::: "memory");
        }
    }
    __syncthreads();
}

namespace pg8 {
constexpr int BM = 256, BK = 64, HALF = 128, HTB = HALF * BK * 2, STAGE_BYTES = 8 * HTB, NXCD = 8, WGM = 8;
DI int lds_byte(int r, int c) { const int st = (r >> 4) * 2 + (c >> 5), rr = r & 15, cc = c & 31, ob = rr * 64 + cc * 2; return st * 1024 + (ob ^ (((ob >> 9) & 1) << 5)); }
DI void stage_rc(int b, int& R, int& C) { const int st = b / 1024, sb = b % 1024, swz = sb ^ (((sb >> 9) & 1) << 5); R = (st >> 1) * 16 + swz / 64; C = (st & 1) * 32 + (swz % 64) / 2; }
DI int perm32(int rho) { const int n = rho >> 4, i = rho & 15; return 8 * (i >> 2) + 4 * n + (i & 3); }

struct Unit { int arow, orow, ocol, e, pos0, cnt; const u8* bt; };

struct StaticOrder {
    static constexpr bool GATHER = false;
    int nM, nN, nwg, G, c, Kb; const u8* Bt;
    DI void init(int M, int N, int K_, const bf16* Bt_, int G_, int c_) { nM = M / BM; nN = N / BM; nwg = nM * nN; G = G_; c = opq_s(c_); Kb = 2 * K_; Bt = (const u8*)Bt_; }
    DI bool next(int i, Unit& u) const {
        const long L = (long)i * G + c; if (L >= nwg) return false;
        int wgid = (int)L; { const int q = nwg / NXCD, r = nwg % NXCD, xcd = wgid % NXCD, off = wgid / NXCD; wgid = (xcd < r ? xcd * (q + 1) : r * (q + 1) + (xcd - r) * q) + off; }
        const int nig = WGM * nN, gid = wgid / nig, fm = gid * WGM, gsz = (nM - fm) < WGM ? (nM - fm) : WGM;
        const int pm = fm + ((wgid % nig) % gsz), pn = (wgid % nig) / gsz;
        u.arow = pm * BM; u.orow = pm * BM; u.ocol = pn * BM; u.e = 0; u.pos0 = 0; u.cnt = 0; u.bt = Bt + (size_t)pn * BM * Kb; return true;
    }
};
template <bool GATHER_>
struct MoeOrderT {
    static constexpr bool GATHER = GATHER_;
    const LAS int* tb; const LAS int* cnt; int NP, G, c, Kb, hd_a; const u8* wt; size_t estride; const unsigned long long* sg;
    DI bool next(int i, Unit& u) const {
        const int L = i * G + opq_s(c), gi = L / NP; const int total = __builtin_amdgcn_readfirstlane(tb[32]) * NP, e = __builtin_amdgcn_readfirstlane(tb[176 + (gi < 320 ? gi : 0)]);
        if (L >= total) return false;
        const int t0 = __builtin_amdgcn_readfirstlane(tb[e]), mte = __builtin_amdgcn_readfirstlane(tb[e + 1]) - t0; const int r = L - t0 * NP; const int pn = r / mte, mt = r - pn * mte;
        u.e = e; u.pos0 = mt * BM; u.cnt = __builtin_amdgcn_readfirstlane(cnt[e]);
        u.arow = hd_a ? (t0 + mt) * BM : GATHER ? 0 : e * ECAP + mt * BM;
        u.orow = (t0 + mt) * BM; u.ocol = pn * BM;
        u.bt = wt + (size_t)e * estride + (size_t)pn * BM * Kb; return true;
    }
};

DI unsigned cvt_pk_bf16(float lo, float hi) { return pk2(lo, hi); }

struct EpiBf16 {
    static constexpr bool PERM = true;
    bf16* O; int ldc; float scale;
    static constexpr bool EARLY = false;
    struct Pre { };
    DI void pre_dma(LAS unsigned char*, const Unit&, int, int) const { }
    DI void pre_lds(Pre&, const LAS unsigned char*, const Unit&, int, int, int, int) const { }
    DI void pre(Pre&, const Unit&, int, int, int, int) const { }
    DI void run(const f32x4 (&acc)[2][2][4][2], const Unit& u, int wr, int wc, int fr, int fq, const Pre&) const {
        const int row0 = u.orow + wr * 64 + fr, col0 = u.ocol + wc * 32 + 8 * fq;
#pragma unroll
        for (int ai = 0; ai < 2; ++ai)
#pragma unroll
            for (int m = 0; m < 4; ++m) { bf16* rowp = O + (size_t)(row0 + ai * HALF + m * 16) * ldc + col0;
#pragma unroll
                for (int bj = 0; bj < 2; ++bj) { const f32x4 v0 = acc[ai][bj][m][0] * scale, v1 = acc[ai][bj][m][1] * scale;
                    u32x4 w; w.x = cvt_pk_bf16(v0[0], v0[1]); w.y = cvt_pk_bf16(v0[2], v0[3]); w.z = cvt_pk_bf16(v1[0], v1[1]); w.w = cvt_pk_bf16(v1[2], v1[3]);
                    *(u32x4*)(rowp + bj * HALF) = w; } }
    }
};
struct EpiSwiGLU {
    static constexpr bool PERM = true;
    bf16* HD; const float* bg; const float* bu;
    static constexpr bool EARLY = G3_EARLY;
    struct Pre { f32x4 gv[2], uv[2]; };
    DI void pre_dma(LAS unsigned char* aux, const Unit& u, int wid, int lane) const {
        if (wid < 4) { const float* src = bg; if (wid >= 2) src = bu; src += u.e * 1024 + (u.ocol >> 1) + 64 * (wid & 1);
            unsigned vo_ = (unsigned)lane * 4u; asm volatile("" : "+v"(vo_));
            __builtin_amdgcn_global_load_lds((const unsigned*)((const char*)src + vo_), (LAS unsigned*)(aux + wid * 256), 4, 0, 0); } }
    DI void pre_lds(Pre& P, const LAS unsigned char* aux, const Unit&, int, int wc, int, int fq) const { const int jl = wc * 32 + 8 * fq;
#pragma unroll
        for (int n = 0; n < 2; ++n) { P.gv[n] = *(const LAS f32x4*)(aux + (jl + 4 * n) * 4); P.uv[n] = *(const LAS f32x4*)(aux + 512 + (jl + 4 * n) * 4); } }
    DI void pre(Pre& P, const Unit& u, int, int wc, int, int fq) const { const int j0 = (u.ocol >> 1) + wc * 32 + 8 * fq;
#pragma unroll
        for (int n = 0; n < 2; ++n) { P.gv[n] = *(const f32x4*)(bg + u.e * 1024 + j0 + 4 * n); P.uv[n] = *(const f32x4*)(bu + u.e * 1024 + j0 + 4 * n); } }
    DI void run(const f32x4 (&acc)[2][2][4][2], const Unit& u, int wr, int wc, int fr, int fq, const Pre& P) const {
        const int row0 = u.orow + wr * 64 + fr, j0 = (u.ocol >> 1) + wc * 32 + 8 * fq;
        const f32x4 (&gv)[2] = P.gv; const f32x4 (&uv)[2] = P.uv;
#pragma unroll
        for (int ai = 0; ai < 2; ++ai)
#pragma unroll
            for (int m = 0; m < 4; ++m) { const size_t eo = (size_t)(row0 + ai * HALF + m * 16) * 1024 + j0; float h[8];
#pragma unroll
                for (int n = 0; n < 2; ++n) {
                    f32x4 g4 = acc[ai][0][m][n] + gv[n], u4 = acc[ai][1][m][n] + uv[n];
                    g4 = __builtin_elementwise_min(g4, (f32x4){7.f, 7.f, 7.f, 7.f});
                    u4 = __builtin_elementwise_min(__builtin_elementwise_max(u4, (f32x4){-7.f, -7.f, -7.f, -7.f}), (f32x4){7.f, 7.f, 7.f, 7.f});
                    const f32x4 x4 = g4 * (-1.702f * 1.4426950408889634f); f32x4 d4;
#pragma unroll
                    for (int v = 0; v < 4; ++v) d4[v] = __builtin_amdgcn_exp2f(x4[v]);
                    d4 = d4 + 1.0f; f32x4 r4;
#pragma unroll
                    for (int v = 0; v < 4; ++v) r4[v] = __builtin_amdgcn_rcpf(d4[v]);
                    const f32x4 h4 = (g4 * r4) * (u4 + 1.0f);
#pragma unroll
                    for (int v = 0; v < 4; ++v) h[4 * n + v] = h4[v]; }
                if constexpr (MOE_FP8) { u32x2 w; w.x = pk4_fp8(h[0], h[1], h[2], h[3]); w.y = pk4_fp8(h[4], h[5], h[6], h[7]); *(u32x2*)((u8*)HD + eo) = w; }
                else { u32x4 w; w.x = cvt_pk_bf16(h[0], h[1]); w.y = cvt_pk_bf16(h[2], h[3]); w.z = cvt_pk_bf16(h[4], h[5]); w.w = cvt_pk_bf16(h[6], h[7]); *(u32x4*)(HD + eo) = w; } }
    }
};
struct EpiDown {
    static constexpr bool PERM = true;
    u8* Y; const float* bd; const unsigned long long* sg;
    static constexpr bool EARLY = G4_EARLY;
    struct Pre { f32x4 bv[2][2]; unsigned long long rec[2][4]; };
    DI void pre_dma(LAS unsigned char* aux, const Unit& u, int wid, int lane) const {
        if (wid < 4) { const float* src = bd + u.e * 1024 + u.ocol + 64 * wid; unsigned vo_ = (unsigned)lane * 4u; asm volatile("" : "+v"(vo_));
            __builtin_amdgcn_global_load_lds((const unsigned*)((const char*)src + vo_), (LAS unsigned*)(aux + wid * 256), 4, 0, 0); }
        else { const int w4 = wid - 4, pos = u.pos0 + 64 * w4 + lane; const unsigned* src = (const unsigned*)(sg + (size_t)u.e * ECAP + (pos < u.cnt ? pos : u.cnt - 1));
            __builtin_amdgcn_global_load_lds(src, (LAS unsigned*)(aux + 1024 + w4 * 256), 4, 0, 0); __builtin_amdgcn_global_load_lds(src + 1, (LAS unsigned*)(aux + 2048 + w4 * 256), 4, 0, 0); } }
    DI void pre_lds(Pre& P, const LAS unsigned char* aux, const Unit&, int wr, int wc, int fr, int fq) const { const int cl = wc * 32 + 8 * fq;
#pragma unroll
        for (int bj = 0; bj < 2; ++bj)
#pragma unroll
            for (int n = 0; n < 2; ++n) P.bv[bj][n] = *(const LAS f32x4*)(aux + (cl + bj * HALF + 4 * n) * 4);
#pragma unroll
        for (int ai = 0; ai < 2; ++ai)
#pragma unroll
            for (int m = 0; m < 4; ++m) { const int r = ai * HALF + wr * 64 + m * 16 + fr; const unsigned lo = *(const LAS unsigned*)(aux + 1024 + 4 * r), hi = *(const LAS unsigned*)(aux + 2048 + 4 * r);
                P.rec[ai][m] = (unsigned long long)lo | ((unsigned long long)hi << 32); } }
    DI void pre(Pre& P, const Unit& u, int wr, int wc, int fr, int fq) const { const int col0 = u.ocol + wc * 32 + 8 * fq;
#pragma unroll
        for (int bj = 0; bj < 2; ++bj)
#pragma unroll
            for (int n = 0; n < 2; ++n) P.bv[bj][n] = *(const f32x4*)(bd + u.e * 1024 + col0 + bj * HALF + 4 * n);
#pragma unroll
        for (int ai = 0; ai < 2; ++ai)
#pragma unroll
            for (int m = 0; m < 4; ++m) { const int pos = u.pos0 + ai * HALF + wr * 64 + m * 16 + fr; P.rec[ai][m] = sg[u.e * ECAP + (pos < u.cnt ? pos : u.cnt - 1)]; } }
    DI void run(const f32x4 (&acc)[2][2][4][2], const Unit& u, int wr, int wc, int fr, int fq, const Pre& P) const {
        const int col0 = u.ocol + wc * 32 + 8 * fq;
        const f32x4 (&bv)[2][2] = P.bv; const unsigned long long (&rec)[2][4] = P.rec;
#pragma unroll
        for (int ai = 0; ai < 2; ++ai)
#pragma unroll
            for (int m = 0; m < 4; ++m) { const int pos = u.pos0 + ai * HALF + wr * 64 + m * 16 + fr;
                if (pos < u.cnt) { const int slot = (int)(unsigned)rec[ai][m]; const float g = __builtin_bit_cast(float, (unsigned)(rec[ai][m] >> 32)) * 16.0f; u8* rowp = Y + (size_t)slot * 1024 + col0;
#pragma unroll
                    for (int bj = 0; bj < 2; ++bj) { const f32x4 v0 = (acc[ai][bj][m][0] + bv[bj][0]) * g, v1 = (acc[ai][bj][m][1] + bv[bj][1]) * g;
                        u32x2 w; w.x = pk4_fp8(v0[0], v0[1], v0[2], v0[3]); w.y = pk4_fp8(v1[0], v1[1], v1[2], v1[3]);
                        *(u32x2*)(rowp + bj * HALF) = w; } } }
    }
};

template <class Epi, class Sched, bool F8>
DI void gemm_phase(LAS unsigned char* lds, const void* A_, int Kb, const Sched& S, const Epi& E) {
    const u8* A = (const u8*)A_;
    const int tid = opq((int)threadIdx.x), wid = __builtin_amdgcn_readfirstlane(tid >> 6), lane = tid & 63, wr = wid >> 2, wc = wid & 3, fr = lane & 15, fq = lane >> 4;
    const int nt = Kb / (2 * BK);
    unsigned voffA[2], voffB[2];
#pragma unroll
    for (int i = 0; i < 2; ++i) { int R, C; stage_rc(tid * 16 + i * 8192, R, C); const int Rb = Epi::PERM ? ((R & ~31) + perm32(R & 31)) : R;
        voffA[i] = (unsigned)(R * Kb + C * 2); voffB[i] = (unsigned)(Rb * Kb + C * 2); }
    const size_t kstep = (size_t)(BK * 2);
    const size_t hstep = (size_t)HALF * Kb;
    unsigned gofc[2][2], recn[2][2];
#define PG8_RECN(u) do { _Pragma("unroll") for (int h_ = 0; h_ < 2; ++h_) _Pragma("unroll") for (int i_ = 0; i_ < 2; ++i_) { const int R_ = (int)(voffA[i_] >> 10) + HALF * h_, p_ = (u).pos0 + R_; \
        const GAS unsigned* rp_ = (const GAS unsigned*)(S.sg + (size_t)(u).e * ECAP + (p_ < (u).cnt ? p_ : (u).cnt - 1)); \
        asm volatile("global_load_dword %0, %1, off" : "=v"(recn[h_][i_]) : "v"(rp_) : "memory"); } } while (0)
#define PG8_ROFF(r, i) ((((r) >> 2) * 1024u) + (voffA[i] & 1023u))
#define PG8_GOFF(g, u) do { unsigned rr_[2][2];     \
        _Pragma("unroll") for (int h_ = 0; h_ < 2; ++h_) _Pragma("unroll") for (int i_ = 0; i_ < 2; ++i_) { const int R_ = (int)(voffA[i_] >> 10) + HALF * h_, p_ = (u).pos0 + R_; \
            rr_[h_][i_] = *((const GAS unsigned*)(S.sg + (size_t)(u).e * ECAP + (p_ < (u).cnt ? p_ : (u).cnt - 1))); }     \
        _Pragma("unroll") for (int h_ = 0; h_ < 2; ++h_) _Pragma("unroll") for (int i_ = 0; i_ < 2; ++i_) g[h_][i_] = (rr_[h_][i_] >> 2) * 1024u + (voffA[i_] & 1023u); } while (0)
    const unsigned ldsw = (unsigned)wid * 1024u;
    const int aoff = lds_byte(wr * 64 + fr, fq * 8), boff = lds_byte(wc * 32 + fr, fq * 8);
#define PG8_SA(b, h) (((b) * 2 + (h)) * HTB)
#define PG8_SB(b, h) ((4 + (b) * 2 + (h)) * HTB)
#define PG8_STAGE(bufoff, gbase, voff) do { _Pragma("unroll") for (int _i = 0; _i < 2; ++_i) { unsigned vo_ = (voff)[_i]; asm volatile("" : "+v"(vo_));     \
        __builtin_amdgcn_global_load_lds((const unsigned*)((const char*)(gbase) + vo_), (LAS unsigned*)(lds + (bufoff) + ldsw + _i * 8192), 16, 0, 0); } } while (0)
#define PG8_STAGE_G(bufoff, gbase, nx, h) do { _Pragma("unroll") for (int _i = 0; _i < 2; ++_i) { unsigned r_ = recn[h][_i]; asm volatile("" : "+v"(r_));     \
        unsigned vo_ = (nx) ? PG8_ROFF(r_, _i) : gofc[h][_i]; asm volatile("" : "+v"(vo_)); \
        __builtin_amdgcn_global_load_lds((const unsigned*)((const char*)(gbase) + vo_), (LAS unsigned*)(lds + (bufoff) + ldsw + _i * 8192), 16, 0, 0); } } while (0)
#define PG8_STA(bufoff, gbase, nx, h) do { if constexpr (Sched::GATHER) PG8_STAGE_G(bufoff, gbase, nx, h); else PG8_STAGE(bufoff, (gbase) + (h) * hstep, voffA); } while (0)
#define PG8_LDA(dst, b, h) do { _Pragma("unroll") for (int m = 0; m < 4; ++m) _Pragma("unroll") for (int k = 0; k < 2; ++k) dst[m][k] = *(const LAS bf16x8*)(lds + PG8_SA(b, h) + aoff + m * 2048 + k * 1024); } while (0)
#define PG8_LDB(dst, b, h) do { _Pragma("unroll") for (int n = 0; n < 2; ++n) _Pragma("unroll") for (int k = 0; k < 2; ++k) dst[n][k] = *(const LAS bf16x8*)(lds + PG8_SB(b, h) + boff + n * 2048 + k * 1024); } while (0)
#define PG8_CAT(x) __builtin_shufflevector(__builtin_bit_cast(i32x4, x[0]), __builtin_bit_cast(i32x4, x[1]), 0, 1, 2, 3, 4, 5, 6, 7)
#define PG8_MMA(ai, bj, At, Bt) do { __builtin_amdgcn_s_setprio(1); _Pragma("unroll") for (int m = 0; m < 4; ++m) _Pragma("unroll") for (int n = 0; n < 2; ++n) { \
        if constexpr (F8) { const i32x8 b8_ = PG8_CAT(Bt[n]), a8_ = PG8_CAT(At[m]);     \
            asm("s_nop 1\n\tv_mfma_scale_f32_16x16x128_f8f6f4 %0, %1, %2, %0, %3, %4 op_sel_hi:[0,0,0]" : "+v"(acc[ai][bj][m][n]) : "v"(b8_), "v"(a8_), "v"(sc_w), "v"(sc_x)); } \
        else { _Pragma("unroll") for (int k = 0; k < 2; ++k) acc[ai][bj][m][n] = __builtin_amdgcn_mfma_f32_16x16x32_bf16(Bt[n][k], At[m][k], acc[ai][bj][m][n], 0, 0, 0); } } \
        __builtin_amdgcn_s_setprio(0); } while (0)
#define PG8_WAIT_V(n) asm volatile("s_waitcnt vmcnt(" #n ")" ::: "memory")
#define PG8_WAIT_L(n) asm volatile("s_waitcnt lgkmcnt(" #n ")" ::: "memory")
#define PG8_BAR __builtin_amdgcn_s_barrier()
#define PG8_SCHED __builtin_amdgcn_sched_barrier(0)
    int sc_w = 121, sc_x = 127;
    if constexpr (F8) asm volatile("" : "+v"(sc_w), "+v"(sc_x));
    Unit cur, nxt; int ui = 0;
    if (!S.next(0, cur)) return;
    f32x4 acc[2][2][4][2];
#pragma unroll
    for (int a = 0; a < 2; ++a)
#pragma unroll
        for (int b = 0; b < 2; ++b)
#pragma unroll
            for (int m = 0; m < 4; ++m)
#pragma unroll
                for (int n = 0; n < 2; ++n) acc[a][b][m][n] = (f32x4){0.f, 0.f, 0.f, 0.f};
    bf16x8 At[4][2], B0[2][2], B1[2][2];
    const char* cA = (const char*)A + (size_t)cur.arow * Kb; const char* cB = (const char*)cur.bt;
    if constexpr (Sched::GATHER) PG8_GOFF(gofc, cur);
    PG8_STAGE(PG8_SB(0, 0), cB, voffB); PG8_STAGE(PG8_SB(0, 1), cB + hstep, voffB); PG8_STA(PG8_SA(0, 0), cA, false, 0); PG8_STA(PG8_SA(0, 1), cA, false, 1);
    if (wr == 1) PG8_BAR;
    PG8_WAIT_V(2); PG8_BAR;
    PG8_STAGE(PG8_SB(1, 0), cB + kstep, voffB); PG8_STA(PG8_SA(1, 0), cA + kstep, false, 0); PG8_STAGE(PG8_SB(1, 1), cB + hstep + kstep, voffB);
    PG8_WAIT_V(6); PG8_BAR;
    for (;;) {
        const bool has_next = S.next(ui + 1, nxt);
        const char* nA = has_next ? (const char*)A + (size_t)nxt.arow * Kb : cA; const char* nB = has_next ? (const char*)nxt.bt : cB;
        if constexpr (Sched::GATHER) { Unit un_ = cur; if (has_next) un_ = nxt; PG8_RECN(un_); }
#pragma nounroll
        for (int t = 0; t < nt; t += 2) {
            const bool last = (t == nt - 2);
            if constexpr (Epi::EARLY) { if (last) E.pre_dma(lds + STAGE_BYTES, cur, wid, lane); }
            const char* a1 = cA + (size_t)(t + 1) * kstep;
            const char* a2 = last ? nA : cA + (size_t)(t + 2) * kstep; const char* b2 = last ? nB : cB + (size_t)(t + 2) * kstep;
            const char* a3 = a2 + kstep; const char* b3 = b2 + kstep;
            PG8_LDB(B0, 0, 0); PG8_LDB(B1, 0, 1); PG8_SCHED; PG8_LDA(At, 0, 0); PG8_STA(PG8_SA(1, 1), a1, false, 1);
            PG8_WAIT_V(8); PG8_WAIT_L(0); PG8_BAR; PG8_MMA(0, 0, At, B0); PG8_MMA(0, 1, At, B1); PG8_BAR; PG8_SCHED;
            PG8_LDA(At, 0, 1); PG8_STAGE(PG8_SB(0, 0), b2, voffB); PG8_STAGE(PG8_SB(0, 1), b2 + hstep, voffB); PG8_STA(PG8_SA(0, 0), a2, last, 0);
            PG8_WAIT_V(8); PG8_WAIT_L(0); PG8_BAR; PG8_MMA(1, 0, At, B0); PG8_MMA(1, 1, At, B1); PG8_BAR; PG8_SCHED;
            PG8_LDB(B0, 1, 0); PG8_LDB(B1, 1, 1); PG8_SCHED; PG8_LDA(At, 1, 0); PG8_STA(PG8_SA(0, 1), a2, last, 1);
            PG8_WAIT_V(8); PG8_WAIT_L(0); PG8_BAR; PG8_MMA(0, 0, At, B0); PG8_MMA(0, 1, At, B1); PG8_BAR; PG8_SCHED;
            PG8_LDA(At, 1, 1); PG8_STAGE(PG8_SB(1, 0), b3, voffB); PG8_STAGE(PG8_SB(1, 1), b3 + hstep, voffB); PG8_STA(PG8_SA(1, 0), a3, last, 0);
            PG8_WAIT_V(8); PG8_WAIT_L(0); PG8_BAR; PG8_MMA(1, 0, At, B0); PG8_MMA(1, 1, At, B1); PG8_BAR; PG8_SCHED;
        }
        if (wr == 0) PG8_BAR;
        if constexpr (F8) asm volatile("s_nop 15\n\ts_nop 15" ::: "memory");
        { typename Epi::Pre P; if constexpr (Epi::EARLY) E.pre_lds(P, lds + STAGE_BYTES, cur, wr, wc, fr, fq); else E.pre(P, cur, wr, wc, fr, fq);
          E.run(acc, cur, wr, wc, fr, fq, P); }
        if (!has_next) break;
#pragma unroll
        for (int a = 0; a < 2; ++a)
#pragma unroll
            for (int b = 0; b < 2; ++b)
#pragma unroll
                for (int m = 0; m < 4; ++m)
#pragma unroll
                    for (int n = 0; n < 2; ++n) acc[a][b][m][n] = (f32x4){0.f, 0.f, 0.f, 0.f};
        cur = nxt; cA = nA; cB = nB; ++ui;
        if constexpr (Sched::GATHER) { _Pragma("unroll") for (int h_ = 0; h_ < 2; ++h_) _Pragma("unroll") for (int i_ = 0; i_ < 2; ++i_) { unsigned r_ = recn[h_][i_]; asm volatile("" : "+v"(r_)); gofc[h_][i_] = PG8_ROFF(r_, i_); } }
        if (wr == 1) PG8_BAR;
    }
    PG8_WAIT_V(0);
    PG8_BAR;
#undef PG8_SA
#undef PG8_SB
#undef PG8_STAGE
#undef PG8_STAGE_G
#undef PG8_STA
#undef PG8_GOFF
#undef PG8_RECN
#undef PG8_ROFF
#undef PG8_LDA
#undef PG8_LDB
#undef PG8_MMA
#undef PG8_CAT
#undef PG8_WAIT_V
#undef PG8_WAIT_L
#undef PG8_BAR
#undef PG8_SCHED
}
}

struct Frame {
    LAS unsigned char* lds;
    LAS int* LC;
    gu32* ctl;
    unsigned char* ws;
    int tid, lane, wave, vcu, G;
};

DI void cvt_tile(const float* W, int N, bf16* WT, int ldt, int k0, int n0, int drow0, LAS float* scr, int lane_) {
    const int lane = opq(lane_);
    const int kr = lane >> 4, c4 = lane & 15;
#pragma unroll 4
    for (int i = 0; i < 16; ++i) { const int kk = 4 * i + kr;
        const f32x4 v = *(const GAS f32x4*)(W + (size_t)(k0 + kk) * N + n0 + 4 * c4);
        LAS float* d = scr + kk * 65 + 4 * c4; d[0] = v.x; d[1] = v.y; d[2] = v.z; d[3] = v.w; }
    LDS_WAIT();
    const int c = lane & 7, nr = lane >> 3;
#pragma unroll
    for (int j = 0; j < 8; ++j) { const int n = nr + 8 * j; const LAS float* s = scr + (8 * c) * 65 + n;
        u32x4 o; o.x = pk2(s[0], s[65]); o.y = pk2(s[130], s[195]); o.z = pk2(s[260], s[325]); o.w = pk2(s[390], s[455]);
        *(GAS u32x4*)(WT + (size_t)(drow0 + n) * ldt + k0 + 8 * c) = o; }
    LDS_WAIT();
}
DI void cvt_tile_f8(const float* W, int N, u8* WT, int ldt, int k0, int n0, int drow0, LAS float* scr, int lane_) {
    const int lane = opq(lane_);
    const int kr = lane >> 4, c4 = lane & 15;
    f32x4 v[16];
#pragma unroll
    for (int i = 0; i < 16; ++i) v[i] = __builtin_nontemporal_load((const GAS f32x4*)(W + (size_t)(k0 + 4 * i + kr) * N + n0 + 4 * c4));
#pragma unroll
    for (int i = 0; i < 16; ++i) { LAS float* d = scr + (4 * i + kr) * 65 + 4 * c4; d[0] = v[i].x; d[1] = v[i].y; d[2] = v[i].z; d[3] = v[i].w; }
    LDS_WAIT();
    const int c = lane & 3, nr = lane >> 2;
#pragma unroll
    for (int j = 0; j < 4; ++j) { const int n = nr + 16 * j; const LAS float* s = scr + (16 * c) * 65 + n;
        u32x4 o; o.x = pk4_fp8(s[0] * 64.f, s[65] * 64.f, s[130] * 64.f, s[195] * 64.f); o.y = pk4_fp8(s[260] * 64.f, s[325] * 64.f, s[390] * 64.f, s[455] * 64.f);
        o.z = pk4_fp8(s[520] * 64.f, s[585] * 64.f, s[650] * 64.f, s[715] * 64.f); o.w = pk4_fp8(s[780] * 64.f, s[845] * 64.f, s[910] * 64.f, s[975] * 64.f);
        *(GAS u32x4*)(WT + (size_t)(drow0 + n) * ldt + k0 + 16 * c) = o; }
    LDS_WAIT();
}
enum { MAP_ID = 0, MAP_GATE = 1, MAP_UP = 2, MAP_UKV = 3 };
DI int map_row(int kind, int n0) {
    if (kind == MAP_GATE) return (n0 >> 7) * 256 + (n0 & 127);
    if (kind == MAP_UP) return (n0 >> 7) * 256 + 128 + (n0 & 127);
    if (kind == MAP_UKV) { const int hh = n0 >> 8, c = n0 & 255; return c < 128 ? hh * 128 + c : 1024 + hh * 128 + (c - 128); }
    return n0;
}
DI void cvt_matrix(Frame& F, const float* W, int K, int N, bf16* WT, int kind, int& base) {
    const int NGW = F.G * NWAVES, gw = opq_s(F.vcu * NWAVES + F.wave), nk = K / 64, nn = N / 64, nit = nk * nn;
    LAS float* scr = (LAS float*)(F.lds + F.wave * 16640);
    int first = (gw - base % NGW + NGW) % NGW;
    for (int it = first; it < nit; it += NGW) { const int kb = it / nn, nb = it - kb * nn; cvt_tile(W, N, WT, K, 64 * kb, 64 * nb, map_row(kind, 64 * nb), scr, F.lane); }
    base += nit;
}
DI void cvt_moe_range(Frame& F, const float* wg, const float* wu, const float* wd, int layer, bf16* buf, int k0, int k1, int base) {
    const int NGW = F.G * NWAVES, gw = opq_s(F.vcu * NWAVES + F.wave);
    LAS float* scr = (LAS float*)(F.lds + F.wave * 16640);
    const size_t lo = (size_t)layer * NEXP * 1024 * 1024;
    for (int k = k0; k < k1; ++k) {
        const int it = base + gw + NGW * k; if (it >= 3 * NEXP * 256) break;
        const int mat = it >> 8, t = it & 255, kb = t >> 4, nb = t & 15, which = mat / NEXP, e = mat - which * NEXP;
        const float* W = (which == 0 ? wg : which == 1 ? wu : wd) + lo + (size_t)e * 1024 * 1024;
        const int drow = map_row(which == 0 ? MAP_GATE : which == 1 ? MAP_UP : MAP_ID, 64 * nb);
        if constexpr (MOE_FP8) { u8* WT = which == 2 ? (u8*)buf + MW_DN + (size_t)e * 1024 * 1024 : (u8*)buf + (size_t)e * 2048 * 1024; cvt_tile_f8(W, 1024, WT, 1024, 64 * kb, 64 * nb, drow, scr, F.lane); }
        else { bf16* WT = which == 2 ? (bf16*)((u8*)buf + MW_DN) + (size_t)e * 1024 * 1024 : buf + (size_t)e * 2048 * 1024; cvt_tile(W, 1024, WT, 1024, 64 * kb, 64 * nb, drow, scr, F.lane); }
    }
}
DI void cvt_moe_stream(Frame& F, const float* wg, const float* wu, const float* wd, int layer, u8* buf, int first, int step, int count) {
    const int lane = opq(F.lane), kr = lane >> 4, c4 = lane & 15, c = lane & 3, nr = lane >> 2;
    LAS float* scr = (LAS float*)(F.lds + F.wave * 16640);
    const size_t lo = (size_t)layer * NEXP * 1024 * 1024;
    f32x4 va[16], vb[16];
    const unsigned voff = (unsigned)(kr * 1024 + 4 * c4) * 4u;
#define CS_SRC(it_) ((((it_) >> 8) / NEXP == 0 ? wg : ((it_) >> 8) / NEXP == 1 ? wu : wd) + lo + (size_t)(((it_) >> 8) % NEXP) * 1024 * 1024 + (size_t)(64 * (((it_) & 255) >> 4)) * 1024 + 64 * ((it_) & 15))
#define CS_LOAD(V, it_) do { const float* W_ = CS_SRC(it_); _Pragma("unroll") for (int i = 0; i < 16; ++i) { const float* b_ = W_ + (size_t)(4 * i) * 1024;     \
        asm volatile("global_load_dwordx4 %0, %1, %2 nt" : "=v"(V[i]) : "v"(voff), "s"(b_) : "memory"); } } while (0)
#define CS_WAIT(V, N) asm volatile("s_waitcnt vmcnt(" #N ")" : "+v"(V[0]), "+v"(V[1]), "+v"(V[2]), "+v"(V[3]), "+v"(V[4]), "+v"(V[5]), "+v"(V[6]), "+v"(V[7]), \
        "+v"(V[8]), "+v"(V[9]), "+v"(V[10]), "+v"(V[11]), "+v"(V[12]), "+v"(V[13]), "+v"(V[14]), "+v"(V[15]) :: "memory")
#define CS_PROC(V, it_) do { const int mat_ = (it_) >> 8, t_ = (it_) & 255, kb_ = t_ >> 4, nb_ = t_ & 15, which_ = mat_ / NEXP, e_ = mat_ - which_ * NEXP; \
        u8* WT_ = which_ == 2 ? buf + MW_DN + (size_t)e_ * 1024 * 1024 : buf + (size_t)e_ * 2048 * 1024; \
        const int drow_ = map_row(which_ == 0 ? MAP_GATE : which_ == 1 ? MAP_UP : MAP_ID, 64 * nb_); \
        _Pragma("unroll") for (int i = 0; i < 16; ++i) { LAS float* d = scr + (4 * i + kr) * 65 + 4 * c4; d[0] = V[i].x; d[1] = V[i].y; d[2] = V[i].z; d[3] = V[i].w; } \
        LDS_WAIT(); \
        _Pragma("unroll") for (int j = 0; j < 4; ++j) { const int n = nr + 16 * j; const LAS float* s = scr + (16 * c) * 65 + n; \
            u32x4 o; o.x = pk4_fp8(s[0] * 64.f, s[65] * 64.f, s[130] * 64.f, s[195] * 64.f); o.y = pk4_fp8(s[260] * 64.f, s[325] * 64.f, s[390] * 64.f, s[455] * 64.f); \
            o.z = pk4_fp8(s[520] * 64.f, s[585] * 64.f, s[650] * 64.f, s[715] * 64.f); o.w = pk4_fp8(s[780] * 64.f, s[845] * 64.f, s[910] * 64.f, s[975] * 64.f); \
            *(GAS u32x4*)(WT_ + (size_t)(drow_ + n) * 1024 + 64 * kb_ + 16 * c) = o; } \
        LDS_WAIT(); } while (0)
    if (count <= 0) return;
    CS_LOAD(va, first);
    for (int k = 0; k < count; k += 2) {
        const int ita = first + step * k, itb = ita + step, itc = (k + 2 < count) ? itb + step : itb;
        CS_LOAD(vb, itb); CS_WAIT(va, 16);
        CS_PROC(va, ita);
        CS_LOAD(va, itc); CS_WAIT(vb, 16);
        CS_PROC(vb, itb);
    }
    CS_WAIT(va, 0);
#undef CS_SRC
#undef CS_WAIT
#undef CS_LOAD
#undef CS_PROC
}
DI void cvt_moe_layer(Frame& F, const float* wg, const float* wu, const float* wd, int layer, bf16* buf, int base) {
    base = __builtin_amdgcn_readfirstlane(base);
    cvt_moe_range(F, wg, wu, wd, layer, buf, 0, (3 * NEXP * 256 - base + F.G * NWAVES - 1) / (F.G * NWAVES), base);
}

DI void ln_rows_finish(f32x4 (&v)[4], const float* g, const float* b, int lane) {
    float s = 0.f;
#pragma unroll
    for (int j = 0; j < 4; ++j) s += (v[j].x + v[j].y) + (v[j].z + v[j].w);
    const float mean = wave_sum(s) * (1.f / DM); float s2 = 0.f;
#pragma unroll
    for (int j = 0; j < 4; ++j) { v[j] = v[j] - mean; s2 += (v[j].x * v[j].x + v[j].y * v[j].y) + (v[j].z * v[j].z + v[j].w * v[j].w); }
    const float rstd = 1.f / sqrtf(wave_sum(s2) * (1.f / DM) + LN_EPS);
#pragma unroll
    for (int j = 0; j < 4; ++j) { const f32x4 gg = *(const GAS f32x4*)(g + 4 * lane + 256 * j), bb = *(const GAS f32x4*)(b + 4 * lane + 256 * j); v[j] = v[j] * rstd * gg + bb; }
}

DI void ln_pair_finish(f32x4 (&a)[4], f32x4 (&c)[4], const f32x4 (&gg)[4], const f32x4 (&bb)[4]) {
    float sa = 0.f, sc = 0.f;
#pragma unroll
    for (int j = 0; j < 4; ++j) { sa += (a[j].x + a[j].y) + (a[j].z + a[j].w); sc += (c[j].x + c[j].y) + (c[j].z + c[j].w); }
    sa = wave_sum(sa); sc = wave_sum(sc);
    const float ma = sa * (1.f / DM), mc = sc * (1.f / DM); float qa = 0.f, qc = 0.f;
#pragma unroll
    for (int j = 0; j < 4; ++j) { a[j] = a[j] - ma; c[j] = c[j] - mc; qa += (a[j].x * a[j].x + a[j].y * a[j].y) + (a[j].z * a[j].z + a[j].w * a[j].w); qc += (c[j].x * c[j].x + c[j].y * c[j].y) + (c[j].z * c[j].z + c[j].w * c[j].w); }
    qa = wave_sum(qa); qc = wave_sum(qc);
    const float ra = __builtin_amdgcn_rsqf(qa * (1.f / DM) + LN_EPS), rc = __builtin_amdgcn_rsqf(qc * (1.f / DM) + LN_EPS);
#pragma unroll
    for (int j = 0; j < 4; ++j) { a[j] = a[j] * ra * gg[j] + bb[j]; c[j] = c[j] * rc * gg[j] + bb[j]; }
}

#define MFMA32(a, b, c) __builtin_amdgcn_mfma_f32_32x32x16_bf16((a), (b), (c), 0, 0, 0)
constexpr int SBL_KP = 144, SBL_VP = 1056, SBL_KB = 512 * SBL_KP;
DI void sb_attn_block(Frame& F, const bf16* QK, const bf16* Vt, bf16* AO, int b, int h, int qb8, int cit, const float* cwg, const float* cwu, const float* cwd, int clayer, u8* cbuf) {
    const int tid = opq(F.tid), lane = tid & 63, w = F.wave, j = lane & 31, G = lane >> 5;
    const int pj = 16 * ((j >> 2) & 1) + 4 * (j >> 3) + (j & 3);
    LAS unsigned char* kimg = F.lds; LAS unsigned char* vimg = F.lds + SBL_KB;
    const int q0 = qb8 * 256, kbase = q0 - 256;
    const size_t tokb = (size_t)b * SEQ;
    const int t0 = q0 + 32 * w;
    const size_t tokq = tokb + t0 + j;
    bf16x8 qf[4];
#pragma unroll
    for (int s = 0; s < 4; ++s) qf[s] = *(const GAS bf16x8*)(QK + tokq * 2048 + h * 64 + 16 * s + 8 * G);
    {
        u32x4 kv[8], vv[8];
#pragma unroll
        for (int i = 0; i < 8; ++i) { const int id = tid + 512 * i, row = id >> 3, c = id & 7; const int kpos = kbase + row < 0 ? 0 : kbase + row;
            kv[i] = *(const GAS u32x4*)(QK + (tokb + kpos) * 2048 + 1024 + h * 64 + 8 * c); }
#pragma unroll
        for (int i = 0; i < 8; ++i) { const int id = tid + 512 * i, row = id >> 6, c = id & 63; const int kpos = kbase + 8 * c < 0 ? 0 : kbase + 8 * c;
            vv[i] = *(const GAS u32x4*)(Vt + (size_t)(h * 64 + row) * NTOK + tokb + kpos); }
        __syncthreads();
#pragma unroll
        for (int i = 0; i < 8; ++i) { const int id = tid + 512 * i, row = id >> 3, c = id & 7; *(LAS u32x4*)(kimg + row * SBL_KP + (row & 16) + 16 * c) = kv[i]; }
#pragma unroll
        for (int i = 0; i < 8; ++i) { const int id = tid + 512 * i, row = id >> 6, c = id & 63; *(LAS u32x4*)(vimg + row * SBL_VP + (row & 16) + 16 * c) = vv[i]; }
    }
    __syncthreads();
    asm volatile("" ::: "memory");
    unsigned long long cv[32];
    {
        const int ci = cit >= 0 ? cit : 0, mat = ci >> 8, t_ = ci & 255, kb_ = t_ >> 4, nb_ = t_ & 15, which = mat / NEXP, e_ = mat - which * NEXP;
        const float* W_ = (which == 0 ? cwg : which == 1 ? cwu : cwd) + (size_t)clayer * NEXP * 1024 * 1024 + (size_t)e_ * 1024 * 1024 + (size_t)(64 * kb_ + 32 * (w & 1)) * 1024 + 64 * nb_;
#pragma unroll
        for (int kk = 0; kk < 32; ++kk) cv[kk] = __builtin_nontemporal_load((const GAS unsigned long long*)(W_ + (size_t)kk * 1024) + lane);
    }
    asm volatile("" ::: "memory");
    f32x16 o0, o1;
#pragma unroll
    for (int i = 0; i < 16; ++i) { o0[i] = 0.f; o1[i] = 0.f; }
    float carry = 1.f;
    auto tile = [&](const bf16x8 (&kf)[4], const bf16x8 (&vf)[2][2], int kb) __attribute__((always_inline)) -> bool {
        f32x16 z;
#pragma unroll
        for (int i = 0; i < 16; ++i) z[i] = 0.f;
#pragma unroll
        for (int s = 0; s < 4; ++s) z = MFMA32(kf[s], qf[s], z);
        const bool diag = (kb == t0);
        z = z * (0.125f * 1.4426950408889634f);
        float r[16];
#pragma unroll
        for (int i = 0; i < 16; ++i) { z[i] = __builtin_amdgcn_exp2f(fminf(z[i], 60.f)); r[i] = __builtin_amdgcn_rcpf(1.0f + z[i]); }
        if (diag) {
#pragma unroll
            for (int i = 0; i < 16; ++i) r[i] = (16 * G + i) < j ? r[i] : 1.f; }
#pragma unroll
        for (int i = 14; i >= 0; --i) r[i] = r[i + 1] * r[i];
        const float ptot = __shfl_xor(r[0], 32);
        const float base = (G == 0 ? ptot : 1.f) * carry;
        float a[16];
#pragma unroll
        for (int i = 0; i < 16; ++i) a[i] = z[i] * (r[i] * base);
        if (diag) {
#pragma unroll
            for (int i = 0; i < 16; ++i) a[i] = (16 * G + i) < j ? a[i] : 0.f; }
        carry *= r[0] * ptot;
        bf16x8 af[2];
#pragma unroll
        for (int sp = 0; sp < 2; ++sp) { u32x4 p; p.x = pk2(a[8 * sp], a[8 * sp + 1]); p.y = pk2(a[8 * sp + 2], a[8 * sp + 3]); p.z = pk2(a[8 * sp + 4], a[8 * sp + 5]); p.w = pk2(a[8 * sp + 6], a[8 * sp + 7]);
            af[sp] = __builtin_bit_cast(bf16x8, p); }
#pragma unroll
        for (int sp = 0; sp < 2; ++sp) { o0 = MFMA32(vf[0][sp], af[sp], o0); o1 = MFMA32(vf[1][sp], af[sp], o1); }
        return __all(carry == 0.f);
    };
    int kb = t0; bool stop = false;
    for (; kb >= 0 && kb >= kbase; kb -= 32) {
        bf16x8 kf[4], vf[2][2];
        const int lt = (kb - kbase) >> 5;
        const LAS unsigned char* kp = kimg + (lt * 32 + pj) * SBL_KP + (pj & 16) + 16 * G;
#pragma unroll
        for (int s = 0; s < 4; ++s) kf[s] = *(const LAS bf16x8*)(kp + 32 * s);
#pragma unroll
        for (int r = 0; r < 2; ++r)
#pragma unroll
            for (int sp = 0; sp < 2; ++sp) vf[r][sp] = *(const LAS bf16x8*)(vimg + (32 * r + pj) * SBL_VP + (pj & 16) + (lt * 32 + 16 * G + 8 * sp) * 2);
        if (tile(kf, vf, kb)) { stop = true; break; }
    }
    if (!stop)
    for (; kb >= 0; kb -= 32) {
        bf16x8 kf[4], vf[2][2];
        const size_t tokk = tokb + kb + pj;
#pragma unroll
        for (int s = 0; s < 4; ++s) kf[s] = *(const GAS bf16x8*)(QK + tokk * 2048 + 1024 + h * 64 + 16 * s + 8 * G);
#pragma unroll
        for (int r = 0; r < 2; ++r)
#pragma unroll
            for (int sp = 0; sp < 2; ++sp) vf[r][sp] = *(const GAS bf16x8*)(Vt + (size_t)(h * 64 + 32 * r + pj) * NTOK + tokb + kb + 16 * G + 8 * sp);
        if (tile(kf, vf, kb)) break;
    }
    bf16* orow = AO + tokq * 1024 + h * 64 + 16 * G;
#pragma unroll
    for (int hf = 0; hf < 2; ++hf) {
        u32x4 w0, w1;
        w0.x = pk2(o0[8 * hf], o0[8 * hf + 1]); w0.y = pk2(o0[8 * hf + 2], o0[8 * hf + 3]); w0.z = pk2(o0[8 * hf + 4], o0[8 * hf + 5]); w0.w = pk2(o0[8 * hf + 6], o0[8 * hf + 7]);
        w1.x = pk2(o1[8 * hf], o1[8 * hf + 1]); w1.y = pk2(o1[8 * hf + 2], o1[8 * hf + 3]); w1.z = pk2(o1[8 * hf + 4], o1[8 * hf + 5]); w1.w = pk2(o1[8 * hf + 6], o1[8 * hf + 7]);
        *(GAS u32x4*)(orow + 8 * hf) = w0; *(GAS u32x4*)(orow + 32 + 8 * hf) = w1; }
    if (cit >= 0) {
        const int mat = cit >> 8, t_ = cit & 255, kb_ = t_ >> 4, nb_ = t_ & 15, which = mat / NEXP, e_ = mat - which * NEXP;
        const int drow = map_row(which == 0 ? MAP_GATE : which == 1 ? MAP_UP : MAP_ID, 64 * nb_);
        u8* WT_ = cbuf + (which == 2 ? MW_DN + (size_t)e_ * 1024 * 1024 : (size_t)e_ * 2048 * 1024) + (size_t)(drow + 2 * lane) * 1024 + 64 * kb_ + 32 * (w & 1);
#pragma unroll
        for (int c4 = 0; c4 < 2; ++c4) { u32x4 o0_, o1_;
#pragma unroll
            for (int q = 0; q < 4; ++q) {
                o0_[q] = pk4_fp8(__builtin_bit_cast(float, (unsigned)cv[16 * c4 + 4 * q]) * 64.f, __builtin_bit_cast(float, (unsigned)cv[16 * c4 + 4 * q + 1]) * 64.f,
                                 __builtin_bit_cast(float, (unsigned)cv[16 * c4 + 4 * q + 2]) * 64.f, __builtin_bit_cast(float, (unsigned)cv[16 * c4 + 4 * q + 3]) * 64.f);
                o1_[q] = pk4_fp8(__builtin_bit_cast(float, (unsigned)(cv[16 * c4 + 4 * q] >> 32)) * 64.f, __builtin_bit_cast(float, (unsigned)(cv[16 * c4 + 4 * q + 1] >> 32)) * 64.f,
                                 __builtin_bit_cast(float, (unsigned)(cv[16 * c4 + 4 * q + 2] >> 32)) * 64.f, __builtin_bit_cast(float, (unsigned)(cv[16 * c4 + 4 * q + 3] >> 32)) * 64.f); }
            *(GAS u32x4*)(WT_ + 16 * c4) = o0_; *(GAS u32x4*)(WT_ + 1024 + 16 * c4) = o1_; }
    }
}
constexpr int SB_CV = 4;
constexpr int MLA_KP = 416, MLA_VP = 160;
constexpr int MLA_KB = 64 * MLA_KP, MLA_VB = 128 * MLA_VP;
constexpr float MLA_C = 0.07216878364870322f * 1.4426950408889634f;
DI void mla_attn_unit(Frame& F, const bf16* Q, const bf16* Kn, const bf16* KR, const bf16* Vt, const float* CS, bf16* AO, int b, int hh, int qb) {
    const int tid = opq(F.tid), lane = tid & 63, w = F.wave, j = lane & 31, G = lane >> 5;
    const int pj = 16 * ((j >> 2) & 1) + 4 * (j >> 3) + (j & 3);
    LAS unsigned char* kbuf = F.lds; LAS unsigned char* vbuf = F.lds + 2 * MLA_KB;
    const int q0 = qb * 256, qrow = q0 + 32 * w + j;
    const size_t tokq = (size_t)b * SEQ + qrow;
    bf16x8 qf[12];
#pragma unroll
    for (int s = 0; s < 8; ++s) qf[s] = *(const GAS bf16x8*)(Q + tokq * 1536 + hh * 192 + 16 * s + 8 * G);
    {
        const bf16* qr = Q + tokq * 1536 + hh * 192 + 128; const float* cs = CS + tokq * 64;
#pragma unroll
        for (int s = 8; s < 12; ++s) { const int e0 = 16 * (s - 8) + 8 * G, f0 = e0 & 31;
            const u32x4 t1 = *(const GAS u32x4*)(qr + f0), t2 = *(const GAS u32x4*)(qr + 32 + f0);
            const f32x4 c0 = *(const GAS f32x4*)(cs + f0), c1 = *(const GAS f32x4*)(cs + f0 + 4), s0 = *(const GAS f32x4*)(cs + 32 + f0), s1 = *(const GAS f32x4*)(cs + 32 + f0 + 4);
            float o[8];
#pragma unroll
            for (int k = 0; k < 4; ++k) { const unsigned a1 = t1[k], a2 = t2[k];
                const float x1 = bf_lo(a1), y1 = bf_hi(a1), x2 = bf_lo(a2), y2 = bf_hi(a2);
                const float cx = (2 * k < 4) ? c0[2 * k] : c1[2 * k - 4], cy = (2 * k + 1 < 4) ? c0[2 * k + 1] : c1[2 * k + 1 - 4];
                const float sx = (2 * k < 4) ? s0[2 * k] : s1[2 * k - 4], sy = (2 * k + 1 < 4) ? s0[2 * k + 1] : s1[2 * k + 1 - 4];
                if (e0 < 32) { o[2 * k] = x1 * cx - x2 * sx; o[2 * k + 1] = y1 * cy - y2 * sy; }
                else         { o[2 * k] = x2 * cx + x1 * sx; o[2 * k + 1] = y2 * cy + y1 * sy; } }
            u32x4 p; p.x = pk2(o[0], o[1]); p.y = pk2(o[2], o[3]); p.z = pk2(o[4], o[5]); p.w = pk2(o[6], o[7]); qf[s] = __builtin_bit_cast(bf16x8, p); }
    }
    f32x16 o[4];
#pragma unroll
    for (int r = 0; r < 4; ++r)
#pragma unroll
        for (int i = 0; i < 16; ++i) o[r][i] = 0.f;
    float m = -1e30f, l = 0.f;
    const int ntile = (q0 + 256) / 64;
    u32x4 sk[3], sv[2];
    const size_t tokb = (size_t)b * SEQ;
    unsigned ofk[3], ofv[2];
#pragma unroll
    for (int i_ = 0; i_ < 2; ++i_) { const int id = tid + 512 * i_; ofk[i_] = (unsigned)((id >> 4) * 1024 + 8 * (id & 15)) * 2u; }
    ofk[2] = (unsigned)((tid >> 3) * 64 + 8 * (tid & 7)) * 2u;
#pragma unroll
    for (int i_ = 0; i_ < 2; ++i_) { const int id = tid + 512 * i_; ofv[i_] = (unsigned)((id >> 3) * NTOK + 8 * (id & 7)) * 2u; }
#define MLA_LD1(dst, base, off) do { unsigned vo_ = (off); asm volatile("" : "+v"(vo_)); dst = *(const GAS u32x4*)((const char*)(base) + vo_); } while (0)
#define MLA_LOAD(t) do { const int kb_ = (t) * 64; const bf16* kn_ = Kn + (tokb + kb_) * 1024 + hh * 128; const bf16* kr_ = KR + (tokb + kb_) * 64; const bf16* vt_ = Vt + (size_t)(hh * 128) * NTOK + tokb + kb_; \
        MLA_LD1(sk[0], kn_, ofk[0]); MLA_LD1(sk[1], kn_, ofk[1]); MLA_LD1(sk[2], kr_, ofk[2]); MLA_LD1(sv[0], vt_, ofv[0]); MLA_LD1(sv[1], vt_, ofv[1]); } while (0)
#define MLA_STORE(buf) do { \
        _Pragma("unroll") for (int i_ = 0; i_ < 2; ++i_) { const int id = tid + 512 * i_, row = id >> 4, c = id & 15; *(LAS u32x4*)(kbuf + (buf) * MLA_KB + row * MLA_KP + (row & 16) + 16 * c) = sk[i_]; } \
        { const int row = tid >> 3, c = 16 + (tid & 7); *(LAS u32x4*)(kbuf + (buf) * MLA_KB + row * MLA_KP + (row & 16) + 16 * c) = sk[2]; } \
        _Pragma("unroll") for (int i_ = 0; i_ < 2; ++i_) { const int id = tid + 512 * i_, row = id >> 3, c = id & 7; \
            *(LAS u32x4*)(vbuf + (buf) * MLA_VB + row * MLA_VP + (row & 16) + 16 * c) = sv[i_]; } } while (0)
    __syncthreads();
    MLA_LOAD(0); MLA_STORE(0);
    __syncthreads();
    for (int t = 0; t < ntile; ++t) {
        const int buf = t & 1, kb = t * 64;
        if (t + 1 < ntile) MLA_LOAD(t + 1);
        const int wq0 = q0 + 32 * w;
        if (kb <= wq0 + 31) {
            const bool need_mask = (kb + 63 > wq0);
            f32x16 s0, s1;
#pragma unroll
            for (int i = 0; i < 16; ++i) { s0[i] = 0.f; s1[i] = 0.f; }
            const LAS unsigned char* kp = kbuf + buf * MLA_KB + pj * MLA_KP + (pj & 16) + 16 * G;
            {
                bf16x8 ka = *(const LAS bf16x8*)(kp), kb = *(const LAS bf16x8*)(kp + 32 * MLA_KP);
#pragma unroll
                for (int s = 0; s < 12; ++s) { bf16x8 na = ka, nb = kb;
                    if (s < 11) { na = *(const LAS bf16x8*)(kp + 32 * (s + 1)); nb = *(const LAS bf16x8*)(kp + 32 * MLA_KP + 32 * (s + 1)); }
                    __builtin_amdgcn_sched_barrier(0);
                    s0 = MFMA32(ka, qf[s], s0); s1 = MFMA32(kb, qf[s], s1);
                    __builtin_amdgcn_sched_barrier(0);
                    ka = na; kb = nb; }
            }
            float mx = -1e30f;
            if (need_mask) {
#pragma unroll
                for (int i = 0; i < 16; ++i) { const int key = kb + 16 * G + i; if (key > qrow) s0[i] = -1e30f; if (key + 32 > qrow) s1[i] = -1e30f; } }
#pragma unroll
            for (int i = 0; i < 16; ++i) mx = fmaxf(mx, fmaxf(s0[i], s1[i]));
            mx = fmaxf(mx, __shfl_xor(mx, 32));
            const float mn = fmaxf(m, mx); const float nmc = -mn * MLA_C;
            float ps = 0.f;
#pragma unroll
            for (int i = 0; i < 16; ++i) { const float p0 = __builtin_amdgcn_exp2f(__builtin_fmaf(s0[i], MLA_C, nmc)), p1 = __builtin_amdgcn_exp2f(__builtin_fmaf(s1[i], MLA_C, nmc)); s0[i] = p0; s1[i] = p1; ps += p0 + p1; }
            if (__any(mn != m)) {
                const float alpha = __builtin_amdgcn_exp2f((m - mn) * MLA_C); l *= alpha;
#pragma unroll
                for (int r = 0; r < 4; ++r)
#pragma unroll
                    for (int i = 0; i < 16; ++i) o[r][i] *= alpha;
            }
            m = mn; l += ps;
            const LAS unsigned char* vp = vbuf + buf * MLA_VB + pj * MLA_VP + (pj & 16) + 32 * G;
            {
                bf16x8 af[4];
#pragma unroll
                for (int q = 0; q < 4; ++q) { const f32x16& pp = (q >> 1) ? s1 : s0; const int sp = q & 1;
                    u32x4 p; p.x = pk2(pp[8 * sp], pp[8 * sp + 1]); p.y = pk2(pp[8 * sp + 2], pp[8 * sp + 3]); p.z = pk2(pp[8 * sp + 4], pp[8 * sp + 5]); p.w = pk2(pp[8 * sp + 6], pp[8 * sp + 7]);
                    af[q] = __builtin_bit_cast(bf16x8, p); }
#define MLA_VF(idx) (*(const LAS bf16x8*)(vp + 32 * ((idx) & 3) * MLA_VP + (32 * ((idx) >> 3) + 8 * (((idx) >> 2) & 1)) * 2))
                bf16x8 vf = MLA_VF(0);
#pragma unroll
                for (int idx = 0; idx < 16; ++idx) { bf16x8 nv = vf;
                    if (idx < 15) nv = MLA_VF(idx + 1);
                    __builtin_amdgcn_sched_barrier(0);
                    o[idx & 3] = MFMA32(vf, af[idx >> 2], o[idx & 3]);
                    __builtin_amdgcn_sched_barrier(0);
                    vf = nv; }
#undef MLA_VF
            }
        }
        if (t + 1 < ntile) MLA_STORE(buf ^ 1);
        __syncthreads();
    }
#undef MLA_LOAD
#undef MLA_LD1
#undef MLA_STORE
    l += __shfl_xor(l, 32);
    const float inv = 1.0f / l;
    bf16* orow = AO + tokq * 1024 + hh * 128 + 16 * G;
#pragma unroll
    for (int r = 0; r < 4; ++r)
#pragma unroll
        for (int hf = 0; hf < 2; ++hf) { u32x4 wv; wv.x = pk2(o[r][8 * hf] * inv, o[r][8 * hf + 1] * inv); wv.y = pk2(o[r][8 * hf + 2] * inv, o[r][8 * hf + 3] * inv);
            wv.z = pk2(o[r][8 * hf + 4] * inv, o[r][8 * hf + 5] * inv); wv.w = pk2(o[r][8 * hf + 6] * inv, o[r][8 * hf + 7] * inv);
            *(GAS u32x4*)(orow + 32 * r + 8 * hf) = wv; }
}

struct Args { const void* in[23]; float* out; unsigned char* ws; int ph_lo, ph_hi; };
static_assert(sizeof(Args) == 23 * 8 + 8 + 8 + 8, "Args has no padding");

constexpr int PH_PER_LAYER = 9;
constexpr int CVT_QUOTA = 4;
constexpr int CVT_P6_UNUSED = 16384;
constexpr int N_PHASES = 1 + 4 * PH_PER_LAYER;

__global__ void __launch_bounds__(NWAVES * 64, 2) mk_fwd(Args args) {
    extern __shared__ __attribute__((aligned(16))) unsigned char lds[];
    Frame F;
    F.lds = (LAS unsigned char*)lds; F.LC = (LAS int*)(F.lds + LDSCTL_OFF);
    F.tid = threadIdx.x; F.lane = F.tid & 63; F.wave = __builtin_amdgcn_readfirstlane(F.tid >> 6);
    F.G = gridDim.x; { const int bx = blockIdx.x; F.vcu = (F.G % 8 == 0) ? (bx % 8) * (F.G / 8) + bx / 8 : bx; }
    F.ws = args.ws; F.ctl = (gu32*)(args.ws + WS_CTL);
    unsigned char* ws = args.ws;
    for (int u = F.tid; u < (LDS_BYTES - LDSCTL_OFF) / 4; u += NWAVES * 64) F.LC[u] = 0;
    __syncthreads();
    if (F.tid < 23) ((LAS unsigned long long*)(F.LC + 128))[F.tid] = (unsigned long long)args.in[F.tid];
    if (F.tid == 23) ((LAS unsigned long long*)(F.LC + 128))[23] = (unsigned long long)args.out;
    __syncthreads();
#define INP(k) ((const void*)lds_ptr((LAS unsigned long long*)(F.LC + 128) + (k)))
    XcdBarrier bar; bar.bar = (unsigned*)(F.ctl + CW_BAR); bar.x = 0; bar.st = nullptr;
#if !MK_PER_PHASE
    bar = xcd_barrier_post((unsigned*)(F.ctl + CW_BAR), (volatile LAS unsigned*)F.LC);
#endif
    const int lo = args.ph_lo, hi = args.ph_hi;
#define IN(k) (lo <= (k) && (k) < hi)
#if MK_PER_PHASE
#define SEAM(k) do { } while (0)
#else
#define SEAM(k) do { if (IN(k) && IN((k) + 1)) xcd_barrier(bar); } while (0)
#endif
#define WSB (opq_p(ws))
#define HF ((float*)(WSB + WS_HF))
#define HB ((bf16*)(WSB + WS_HB))
#define AO ((bf16*)(WSB + WS_AO))
#define MIX ((bf16*)(WSB + WS_MIX))
#define Y ((bf16*)(WSB + WS_Y))
#define HD ((bf16*)(WSB + WS_HD))
#define XS ((bf16*)(WSB + WS_XS))
#define SLOT ((int*)(WSB + WS_SLOT))
#define GATE ((float*)(WSB + WS_GATE))
    const int gw_ = F.vcu * NWAVES + F.wave, NGW = F.G * NWAVES;
#define gw (opq_s(gw_))

    if (IN(0)) {
        int base = 0;
        for (int s = 0; s < 2; ++s) {
            cvt_matrix(F, (const float*)INP(4) + (size_t)s * 1024 * 3072, 1024, 3072, (bf16*)(ws + WS_SW + SW_SBIN) + (size_t)s * 3072 * 1024, MAP_ID, base);
            cvt_matrix(F, (const float*)INP(5) + (size_t)s * 1024 * 1024, 1024, 1024, (bf16*)(ws + WS_SW + SW_SBOUT) + (size_t)s * 1024 * 1024, MAP_ID, base);
        }
        cvt_matrix(F, (const float*)INP(6), 1024, 3072, (bf16*)(ws + WS_SW + SW_SCIN), MAP_ID, base);
        cvt_matrix(F, (const float*)INP(8), 1024, 1024, (bf16*)(ws + WS_SW + SW_SCOUT), MAP_ID, base);
        cvt_matrix(F, (const float*)INP(9), 1024, 704, (bf16*)(ws + WS_SW + SW_MLIN), MAP_ID, base);
        cvt_matrix(F, (const float*)INP(11), 384, 1536, (bf16*)(ws + WS_SW + SW_MLUQ), MAP_ID, base);
        cvt_matrix(F, (const float*)INP(13), 256, 2048, (bf16*)(ws + WS_SW + SW_MLUKV), MAP_UKV, base);
        cvt_matrix(F, (const float*)INP(14), 1024, 1024, (bf16*)(ws + WS_SW + SW_MLOUT), MAP_ID, base);
        { bf16* z = (bf16*)(ws + WS_SW + SW_MLIN) + (size_t)704 * 1024; for (int i = blockIdx.x * 512 + F.tid; i < 64 * 1024 / 8; i += F.G * 512) *(GAS u32x4*)(z + 8 * i) = (u32x4){0u, 0u, 0u, 0u}; }
        { const float* rw = (const float*)INP(15); bf16* rt = (bf16*)(ws + WS_SW + SW_ROUT);
          for (int i = blockIdx.x * 512 + F.tid; i < 4 * 32 * 1024; i += F.G * 512) { const int l = i >> 15, e = (i >> 10) & 31, k = i & 1023; rt[i] = (bf16)(pk2(rw[(size_t)l * 32768 + k * 32 + e], 0.f) & 0xffffu); } }
        const float* x = (const float*)INP(0);
        for (int i = blockIdx.x * 512 + F.tid; i < NTOK * DM / 8; i += F.G * 512) { const f32x4 a = *(const GAS f32x4*)(x + 8 * (size_t)i), b2 = *(const GAS f32x4*)(x + 8 * (size_t)i + 4);
            u32x4 o; o.x = pk2(a.x, a.y); o.y = pk2(a.z, a.w); o.z = pk2(b2.x, b2.y); o.w = pk2(b2.z, b2.w); *(GAS u32x4*)(HB + 8 * (size_t)i) = o; }
    }
    SEAM(0);

    for (int layer = 0; layer < 4; ++layer) {
        ws = opq_p(ws);
        const int kind = layer % 3, slot = layer / 3, P = 1 + layer * PH_PER_LAYER;
        bf16* mwbuf = (bf16*)(ws + WS_MW + (size_t)(layer & 1) * MW_BUF);
#define NXTBUF ((u8*)(opq_p(ws) + WS_MW + (size_t)((layer + 1) & 1) * MW_BUF))

        if (IN(P + 0)) {
            const bf16* Bt; int N; bf16* O;
            if (kind == 0)      { Bt = (const bf16*)(ws + WS_SW + SW_SBIN) + (size_t)slot * 3072 * 1024; N = 2048; O = (bf16*)(ws + WS_MB + MB_QK); }
            else if (kind == 1) { Bt = (const bf16*)(ws + WS_SW + SW_SCIN); N = 3072; O = (bf16*)(ws + WS_MB + MB_QK); }
            else                { Bt = (const bf16*)(ws + WS_SW + SW_MLIN); N = 768; O = (bf16*)(ws + WS_MB + MB_LAT); }
            { pg8::StaticOrder S; S.init(NTOK, N, 1024, Bt, F.G, (int)blockIdx.x); pg8::EpiBf16 E{O, N, 1.0f};
              pg8::gemm_phase<pg8::EpiBf16, pg8::StaticOrder, false>(F.lds, HB, 2048, S, E); }
            if (kind == 0) {
                const bf16* Wv = (const bf16*)(ws + WS_SW + SW_SBIN) + (size_t)slot * 3072 * 1024 + (size_t)2048 * 1024;
                pg8::StaticOrder S; S.init(1024, NTOK, 1024, HB, F.G, (int)blockIdx.x); pg8::EpiBf16 E{(bf16*)(ws + WS_MB + MB_VT), NTOK, 1.0f};
                pg8::gemm_phase<pg8::EpiBf16, pg8::StaticOrder, false>(F.lds, Wv, 2048, S, E);
            }
        }
        SEAM(P + 0);

        if (IN(P + 1)) {
            if (kind == 0) {
                const bf16* QK = (const bf16*)(ws + WS_MB + MB_QK); const bf16* Vt = (const bf16*)(ws + WS_MB + MB_VT);
                { const int cbase = __builtin_amdgcn_readfirstlane(F.LC[104]); const int k1 = (3 * NEXP * 256 - cbase + NGW - 1) / NGW; int kk = (MOE_FP8 && k1 > SB_CV) ? k1 - SB_CV : (MOE_FP8 ? 0 : k1);
                  const float* cwg = (const float*)INP(17); const float* cwu = (const float*)INP(19); const float* cwd = (const float*)INP(21);
                  cvt_moe_range(F, cwg, cwu, cwd, layer, mwbuf, 0, kk, cbase);
                  for (int u = F.vcu; u < 2 * 16 * 32; u += F.G) { const int bh = u >> 5, qb8 = u & 31; int cit = -1;
                      if (kk < k1) { cit = cbase + (gw_ & ~1) + NGW * kk; if (cit >= 3 * NEXP * 256) cit = -1; ++kk; }
                      sb_attn_block(F, QK, Vt, AO, bh >> 4, bh & 15, qb8, cit, cwg, cwu, cwd, layer, (u8*)mwbuf); }
                  __syncthreads();
                  cvt_moe_range(F, cwg, cwu, cwd, layer, mwbuf, kk, k1, cbase); }
                __syncthreads();
            } else if (kind == 1) {
                const bf16* BCH = (const bf16*)(ws + WS_MB + MB_QK); const float* cw = (const float*)INP(7);
                for (int rb = gw; rb < NTOK / 8; rb += NGW) {
                    const int r0 = rb * 8;
#pragma unroll
                    for (int jj = 0; jj < 2; ++jj) { const int c0 = 512 * jj + 8 * opq(F.lane);
                        float w0[8], w1[8], w2[8], um2[8], um1[8];
#pragma unroll
                        for (int k = 0; k < 8; ++k) { w0[k] = cw[c0 + k]; w1[k] = cw[1024 + c0 + k]; w2[k] = cw[2048 + c0 + k]; um2[k] = 0.f; um1[k] = 0.f; }
                        const bool head = (r0 % SEQ) == 0;
                        u32x4 cv[10], hv[10], bv[8];
#pragma unroll
                        for (int t = 0; t < 10; ++t) { const int row = (t < 2 && head) ? r0 : r0 + t - 2;
                            cv[t] = *(const GAS u32x4*)(BCH + (size_t)row * 3072 + 1024 + c0); hv[t] = *(const GAS u32x4*)(BCH + (size_t)row * 3072 + 2048 + c0); }
#pragma unroll
                        for (int t = 0; t < 8; ++t) bv[t] = *(const GAS u32x4*)(BCH + (size_t)(r0 + t) * 3072 + c0);
#pragma unroll
                        for (int t = 0; t < 10; ++t) { const int row = r0 + t - 2;
                            float u[8];
#pragma unroll
                            for (int k = 0; k < 4; ++k) { u[2 * k] = bf_lo(cv[t][k]) * bf_lo(hv[t][k]); u[2 * k + 1] = bf_hi(cv[t][k]) * bf_hi(hv[t][k]); }
                            if (t < 2 && head) {
#pragma unroll
                                for (int k = 0; k < 8; ++k) u[k] = 0.f; }
                            if (t >= 2) { const u32x4 bvv = bv[t - 2]; float o[8];
#pragma unroll
                                for (int k = 0; k < 4; ++k) { o[2 * k] = bf_lo(bvv[k]) * (w0[2 * k] * um2[2 * k] + w1[2 * k] * um1[2 * k] + w2[2 * k] * u[2 * k]);
                                    o[2 * k + 1] = bf_hi(bvv[k]) * (w0[2 * k + 1] * um2[2 * k + 1] + w1[2 * k + 1] * um1[2 * k + 1] + w2[2 * k + 1] * u[2 * k + 1]); }
                                u32x4 ov; ov.x = pk2(o[0], o[1]); ov.y = pk2(o[2], o[3]); ov.z = pk2(o[4], o[5]); ov.w = pk2(o[6], o[7]);
                                *(GAS u32x4*)(AO + (size_t)row * 1024 + c0) = ov; }
#pragma unroll
                            for (int k = 0; k < 8; ++k) { um2[k] = um1[k]; um1[k] = u[k]; }
                        }
                    }
                }
            } else {
                const bf16* LAT = (const bf16*)(ws + WS_MB + MB_LAT); bf16* QLN = (bf16*)(ws + WS_MB + MB_QLN); bf16* KVLN = (bf16*)(ws + WS_MB + MB_KVLN);
                bf16* KR = (bf16*)(ws + WS_MB + MB_KR); float* CS = (float*)(ws + WS_MB + MB_CS);
                const float* qn = (const float*)INP(10); const float* kvn = (const float*)INP(12); const int* posp = (const int*)INP(1);
                const int l = opq(F.lane);
                float qnw[3][2], kvw[2][2];
#pragma unroll
                for (int jx = 0; jx < 3; ++jx) { qnw[jx][0] = qn[128 * jx + 2 * l]; qnw[jx][1] = qn[128 * jx + 2 * l + 1]; }
#pragma unroll
                for (int jx = 0; jx < 2; ++jx) { kvw[jx][0] = kvn[128 * jx + 2 * l]; kvw[jx][1] = kvn[128 * jx + 2 * l + 1]; }
                for (int rowa = gw; rowa < NTOK; rowa += 8 * NGW) {
                    unsigned vv[8][6]; int pq[8];
#pragma unroll
                    for (int q = 0; q < 8; ++q) { const int rowq = (rowa + q * NGW < NTOK) ? rowa + q * NGW : rowa; const unsigned* lrq = (const unsigned*)(LAT + (size_t)rowq * 768);
#pragma unroll
                        for (int jx = 0; jx < 6; ++jx) vv[q][jx] = lrq[64 * jx + l];
                        pq[q] = posp[rowq]; }
#pragma unroll
                    for (int q = 0; q < 8; ++q) { const int row = rowa + q * NGW; if (row >= NTOK) continue;
                    unsigned v[6];
#pragma unroll
                    for (int jx = 0; jx < 6; ++jx) v[jx] = vv[q][jx];
                    float sq = 0.f, skv = 0.f;
#pragma unroll
                    for (int jx = 0; jx < 3; ++jx) { const float a = bf_lo(v[jx]), b2 = bf_hi(v[jx]); sq += a * a + b2 * b2; }
#pragma unroll
                    for (int jx = 3; jx < 5; ++jx) { const float a = bf_lo(v[jx]), b2 = bf_hi(v[jx]); skv += a * a + b2 * b2; }
                    const float rq = __builtin_amdgcn_rsqf(wave_sum(sq) * (1.0f / 384.0f) + RMS_EPS), rkv = __builtin_amdgcn_rsqf(wave_sum(skv) * (1.0f / 256.0f) + RMS_EPS);
#pragma unroll
                    for (int jx = 0; jx < 3; ++jx) { const int c = 128 * jx + 2 * l; ((unsigned*)(QLN + (size_t)row * 384))[64 * jx + l] = pk2(bf_lo(v[jx]) * rq * qnw[jx][0], bf_hi(v[jx]) * rq * qnw[jx][1]); }
#pragma unroll
                    for (int jx = 3; jx < 5; ++jx) { const int c = 128 * (jx - 3) + 2 * l; ((unsigned*)(KVLN + (size_t)row * 256))[64 * (jx - 3) + l] = pk2(bf_lo(v[jx]) * rkv * kvw[jx - 3][0], bf_hi(v[jx]) * rkv * kvw[jx - 3][1]); }
                    const float pos = (float)pq[q];
                    const int fi = 2 * (l & 15);
                    float cs0, sn0, cs1, sn1;
                    { const double invf0 = (double)(float)exp2(-(double)fi * (13.287712379549449 / 32.0)), invf1 = (double)(float)exp2(-(double)(fi + 1) * (13.287712379549449 / 32.0));
                      const double r0 = (double)pos * invf0 * 0.15915494309189535, r1 = (double)pos * invf1 * 0.15915494309189535;
                      const float f0 = (float)(r0 - rint(r0)), f1 = (float)(r1 - rint(r1));
                      cs0 = __builtin_amdgcn_cosf(f0); sn0 = __builtin_amdgcn_sinf(f0); cs1 = __builtin_amdgcn_cosf(f1); sn1 = __builtin_amdgcn_sinf(f1); }
                    const unsigned mine = v[5], other = __shfl_xor(mine, 16);
                    const float mx = bf_lo(mine), my = bf_hi(mine), ox = bf_lo(other), oy = bf_hi(other);
                    if (l < 32) {
                        float rx, ry;
                        if (l < 16) { rx = mx * cs0 - ox * sn0; ry = my * cs1 - oy * sn1; }
                        else        { rx = mx * cs0 + ox * sn0; ry = my * cs1 + oy * sn1; }
                        ((unsigned*)(KR + (size_t)row * 64))[l] = pk2(rx, ry);
                        if (l < 16) { float* c = CS + (size_t)row * 64; c[fi] = cs0; c[fi + 1] = cs1; c[32 + fi] = sn0; c[32 + fi + 1] = sn1; }
                    }
                    }
                }
            }
        }
        SEAM(P + 1);

        if (kind == 2) {
            if (IN(P + 2)) {
                const bf16* QLN = (const bf16*)(ws + WS_MB + MB_QLN); const bf16* KVLN = (const bf16*)(ws + WS_MB + MB_KVLN);
                const bf16* Wuq = (const bf16*)(ws + WS_SW + SW_MLUQ); const bf16* Wk = (const bf16*)(ws + WS_SW + SW_MLUKV); const bf16* Wv = Wk + (size_t)1024 * 256;
                for (int gi = 0; gi < 3; ++gi) {
                    const bf16* A = gi == 0 ? QLN : gi == 1 ? KVLN : Wv; const bf16* Bt = gi == 0 ? Wuq : gi == 1 ? Wk : KVLN;
                    const int M = gi == 2 ? 1024 : NTOK, N = gi == 0 ? 1536 : gi == 1 ? 1024 : NTOK, K = gi == 0 ? 384 : 256;
                    bf16* O = (bf16*)(ws + WS_MB + (gi == 0 ? MB_Q : gi == 1 ? MB_KN : MB_MVT));
                    pg8::StaticOrder S; S.init(M, N, K, Bt, F.G, (int)blockIdx.x); pg8::EpiBf16 E{O, N, 1.0f};
                    pg8::gemm_phase<pg8::EpiBf16, pg8::StaticOrder, false>(F.lds, A, 2 * K, S, E);
                }
            }
            SEAM(P + 2);
            if (IN(P + 3)) {
                const bf16* Q = (const bf16*)(ws + WS_MB + MB_Q); const bf16* Kn = (const bf16*)(ws + WS_MB + MB_KN); const bf16* KR = (const bf16*)(ws + WS_MB + MB_KR);
                const bf16* Vt = (const bf16*)(ws + WS_MB + MB_MVT); const float* CS = (const float*)(ws + WS_MB + MB_CS);
                for (int p = (int)blockIdx.x; p < 256; p += F.G) { const int bh = p >> 4, xq = p & 15;
                    mla_attn_unit(F, Q, Kn, KR, Vt, CS, AO, bh >> 3, bh & 7, 31 - xq);
                    mla_attn_unit(F, Q, Kn, KR, Vt, CS, AO, bh >> 3, bh & 7, xq); }
                __syncthreads();
            }
            SEAM(P + 3);
        }

        if (IN(P + 4)) {
            const bf16* Bt = kind == 0 ? (const bf16*)(ws + WS_SW + SW_SBOUT) + (size_t)slot * 1024 * 1024 : kind == 1 ? (const bf16*)(ws + WS_SW + SW_SCOUT) : (const bf16*)(ws + WS_SW + SW_MLOUT);
            pg8::StaticOrder S; S.init(NTOK, 1024, 1024, Bt, F.G, (int)blockIdx.x); pg8::EpiBf16 E{MIX, 1024, 1.0f};
            pg8::gemm_phase<pg8::EpiBf16, pg8::StaticOrder, false>(F.lds, AO, 2048, S, E);
        }
        SEAM(P + 4);

        if (IN(P + 5)) {
            const float* g1 = (const float*)INP(2) + (size_t)(layer * 2 + 0) * 1024; const float* b1 = (const float*)INP(3) + (size_t)(layer * 2 + 0) * 1024;
            const bf16* Rt = (const bf16*)(ws + WS_SW + SW_ROUT) + (size_t)layer * 32 * 1024; const float* rb = (const float*)INP(16) + layer * 32;
            gu32* CNT = F.ctl + CW_CNT + layer * 2048;
            const bf16* hin = HB; bf16* H1p = (bf16*)HF; const bf16* MIXp = MIX; unsigned long long* SGp = (unsigned long long*)SLOT; bf16* XSp = XS;
            LAS unsigned char* rows = F.lds;
            LAS float* lg = (LAS float*)(F.lds + 132096);
            LAS int* dstt = (LAS int*)(F.lds + 140544);
            LAS int* bases = (LAS int*)(F.lds + 141568);
            const int lane = opq(F.lane), fr = lane & 15, fq = lane >> 4, w = F.wave;
            f32x4 lnG[4], lnB[4];
#pragma unroll
            for (int jx = 0; jx < 4; ++jx) { lnG[jx] = *(const GAS f32x4*)(g1 + 4 * lane + 256 * jx); lnB[jx] = *(const GAS f32x4*)(b1 + 4 * lane + 256 * jx); }
            for (int blk = F.vcu; blk < NTOK / 64; blk += F.G) {
                u32x2 rh[8][4], rm[8][4];
#pragma unroll
                for (int r = 0; r < 8; ++r)
#pragma unroll
                    for (int jx = 0; jx < 4; ++jx) { const size_t o = ((size_t)blk * 64 + 8 * w + r) * 1024 + 4 * lane + 256 * jx; rh[r][jx] = *(const GAS u32x2*)(hin + o); rm[r][jx] = *(const GAS u32x2*)(MIXp + o); }
#pragma unroll
                for (int rp = 0; rp < 4; ++rp) { const int lr0 = 8 * w + 2 * rp; const size_t row = (size_t)blk * 64 + lr0;
                    f32x4 va[4], vc[4];
#pragma unroll
                    for (int jx = 0; jx < 4; ++jx) { const u32x2 ha = rh[2 * rp][jx], hc = rh[2 * rp + 1][jx], ma = rm[2 * rp][jx], mc = rm[2 * rp + 1][jx];
                        va[jx] = (f32x4){bf_lo(ha.x), bf_hi(ha.x), bf_lo(ha.y), bf_hi(ha.y)} * DN_ALPHA + (f32x4){bf_lo(ma.x), bf_hi(ma.x), bf_lo(ma.y), bf_hi(ma.y)};
                        vc[jx] = (f32x4){bf_lo(hc.x), bf_hi(hc.x), bf_lo(hc.y), bf_hi(hc.y)} * DN_ALPHA + (f32x4){bf_lo(mc.x), bf_hi(mc.x), bf_lo(mc.y), bf_hi(mc.y)}; }
                    ln_pair_finish(va, vc, lnG, lnB);
#pragma unroll
                    for (int jx = 0; jx < 4; ++jx) { const size_t o = row * 1024 + 4 * lane + 256 * jx;
                        const u32x2 pa = {pk2(va[jx].x, va[jx].y), pk2(va[jx].z, va[jx].w)}, pc = {pk2(vc[jx].x, vc[jx].y), pk2(vc[jx].z, vc[jx].w)};
                        *(GAS u32x2*)(H1p + o) = pa; *(GAS u32x2*)(H1p + o + 1024) = pc;
                        *(LAS u32x2*)(rows + lr0 * 2064 + (4 * lane + 256 * jx) * 2) = pa; *(LAS u32x2*)(rows + (lr0 + 1) * 2064 + (4 * lane + 256 * jx) * 2) = pc; }
                }
                const int tt = w >> 1, et = w & 1;
                bf16x8 wv[32];
                { const bf16* wp = Rt + (size_t)(16 * et + fr) * 1024 + 8 * fq;
#pragma unroll
                  for (int s2 = 0; s2 < 32; ++s2) wv[s2] = *(const GAS bf16x8*)(wp + 32 * s2); }
                const f32x4 rbv = *(const GAS f32x4*)(rb + 16 * et + 4 * fq);
                __syncthreads();
                { f32x4 a0 = {0.f, 0.f, 0.f, 0.f}; const LAS unsigned char* hp = rows + (16 * tt + fr) * 2064 + 16 * fq;
#pragma unroll
                  for (int s2 = 0; s2 < 32; s2 += 8) {
                      bf16x8 hq[8];
#pragma unroll
                      for (int q = 0; q < 8; ++q) hq[q] = *(const LAS bf16x8*)(hp + 64 * (s2 + q));
#pragma unroll
                      for (int q = 0; q < 8; ++q) a0 = __builtin_amdgcn_mfma_f32_16x16x32_bf16(wv[s2 + q], hq[q], a0, 0, 0, 0); }
#pragma unroll
                  for (int vv = 0; vv < 4; ++vv) lg[(16 * tt + fr) * 33 + 16 * et + 4 * fq + vv] = a0[vv] + rbv[vv]; }
                __syncthreads();
                if (w == 0) {
                    float lv[32];
#pragma unroll
                    for (int e = 0; e < 32; ++e) lv[e] = lg[lane * 33 + e];
                    int ce[4]; float cv[4];
#pragma unroll
                    for (int k = 0; k < 4; ++k) { float best = -3.0e38f; int bi = 0;
#pragma unroll
                        for (int e = 0; e < 32; ++e) { bool taken = false;
#pragma unroll
                            for (int q = 0; q < k; ++q) taken = taken || (ce[q] == e);
                            if (!taken && lv[e] > best) { best = lv[e]; bi = e; } }
                        ce[k] = bi; cv[k] = best; }
                    float ex[4], es = 0.f;
#pragma unroll
                    for (int k = 0; k < 4; ++k) { ex[k] = __expf(cv[k] - cv[0]); es += ex[k]; }
                    const float ies = 1.0f / es; const int token = blk * 64 + lane;
                    int rank[4] = {0, 0, 0, 0}; int mycnt = 0; const unsigned long long below = (1ull << lane) - 1ull;
#pragma unroll 1
                    for (int e = 0; e < 32; ++e) { const bool has = (ce[0] == e) | (ce[1] == e) | (ce[2] == e) | (ce[3] == e); const unsigned long long mask = __ballot(has);
                        const int nb = __popcll(mask & below);
#pragma unroll
                        for (int k = 0; k < 4; ++k) rank[k] = (ce[k] == e) ? nb : rank[k];
                        mycnt = (lane == e) ? __popcll(mask) : mycnt; }
                    if (lane < 32) bases[lane] = (int)__hip_atomic_fetch_add(CNT + lane * 64, (unsigned)mycnt, RLX_AGENT);
                    LDS_WAIT();
#pragma unroll
                    for (int k = 0; k < 4; ++k) { const int pos = bases[ce[k]] + rank[k]; const int sl = token * 4 + k; SGp[ce[k] * ECAP + pos] = (unsigned long long)(unsigned)sl | ((unsigned long long)__builtin_bit_cast(unsigned, ex[k] * ies) << 32); dstt[lane * 4 + k] = ce[k] * ECAP + pos; }
                }
                __syncthreads();
                for (int r = 0; r < 8; ++r) {
                    if constexpr (MOE_FP8) {
                        const u32x4 p0 = *(const LAS u32x4*)(rows + (8 * w + r) * 2064 + 32 * lane), p1 = *(const LAS u32x4*)(rows + (8 * w + r) * 2064 + 32 * lane + 16);
                        u32x4 q; q.x = pk4_fp8(bf_lo(p0.x), bf_hi(p0.x), bf_lo(p0.y), bf_hi(p0.y)); q.y = pk4_fp8(bf_lo(p0.z), bf_hi(p0.z), bf_lo(p0.w), bf_hi(p0.w));
                        q.z = pk4_fp8(bf_lo(p1.x), bf_hi(p1.x), bf_lo(p1.y), bf_hi(p1.y)); q.w = pk4_fp8(bf_lo(p1.z), bf_hi(p1.z), bf_lo(p1.w), bf_hi(p1.w));
                        *(GAS u32x4*)((u8*)XSp + (size_t)(blk * 64 + 8 * w + r) * 1024 + 16 * lane) = q;
                    } else {
#pragma unroll
                    for (int k = 0; k < 4; ++k) { const size_t d = (size_t)dstt[(8 * w + r) * 4 + k];
#pragma unroll
                        for (int hh = 0; hh < 2; ++hh) { const int ch = lane + 64 * hh; const u32x4 val = *(const LAS u32x4*)(rows + (8 * w + r) * 2064 + 16 * ch); *(GAS u32x4*)(XSp + d * 1024 + 8 * ch) = val; } }
                    }
                }
                __syncthreads();
            }
            __syncthreads();
            if (kind != 0) cvt_moe_layer(F, (const float*)INP(17), (const float*)INP(19), (const float*)INP(21), layer, mwbuf, F.LC[104]);
            __syncthreads();
        }
        SEAM(P + 5);

        if (IN(P + 6) || IN(P + 7)) {
            if (F.wave == 0) {
                const int t_ = opq(F.lane), el = t_ & 31;
                const int c = (int)__hip_atomic_load(F.ctl + CW_CNT + layer * 2048 + el * 64, RLX_AGENT);
                const int tl = (c + 255) >> 8; int inc = tl;
#pragma unroll
                for (int o = 1; o < 32; o <<= 1) { const int v = __shfl_up(inc, o, 32); if (el >= o) inc += v; }
                if (t_ < 32) { F.LC[64 + t_] = c; F.LC[16 + t_] = inc - tl; }
                if (t_ < 32) { for (int k = 0; k < tl; ++k) F.LC[192 + inc - tl + k] = t_; }
                if (t_ == 31) { const int acc = inc; F.LC[16 + 32] = acc;
                    const bool tc = MOE_FP8 && layer < 3; const int r6 = (8 * acc) % F.G, r7 = (4 * acc) % F.G, i6 = (tc && r6) ? F.G - r6 : 0, i7 = (tc && r7) ? F.G - r7 : 0;
                    F.LC[100] = r6; F.LC[101] = i6; F.LC[102] = r7; F.LC[103] = i7; F.LC[104] = (i6 + i7) * NWAVES * CVT_QUOTA; }
            }
            __syncthreads();
        }
        if (IN(P + 6)) {
            { pg8::MoeOrderT<MOE_FP8 != 0> S{F.LC + 16, F.LC + 64, 8, F.G, F.vcu, 1024 * MOE_EB, 0, (const u8*)mwbuf, (size_t)2048 * 1024 * MOE_EB, (const unsigned long long*)SLOT};
            pg8::EpiSwiGLU E{HD, (const float*)INP(18) + (size_t)layer * 32 * 1024, (const float*)INP(20) + (size_t)layer * 32 * 1024};
            pg8::gemm_phase<pg8::EpiSwiGLU, pg8::MoeOrderT<MOE_FP8 != 0>, MOE_FP8 != 0>(F.lds, XS, 1024 * MOE_EB, S, E); }
            { const int r6 = __builtin_amdgcn_readfirstlane(F.LC[100]), i6 = __builtin_amdgcn_readfirstlane(F.LC[101]);
              if (i6 > 0 && F.vcu >= r6) cvt_moe_stream(F, (const float*)INP(17), (const float*)INP(19), (const float*)INP(21), layer + 1, NXTBUF, (F.vcu - r6) * NWAVES + F.wave, i6 * NWAVES, CVT_QUOTA); }
        }
        SEAM(P + 6);
        if (IN(P + 7)) {
            { pg8::MoeOrderT<false> S{F.LC + 16, F.LC + 64, 4, F.G, F.vcu, 1024 * MOE_EB, 1, (const u8*)mwbuf + MW_DN, (size_t)1024 * 1024 * MOE_EB, (const unsigned long long*)SLOT};
            pg8::EpiDown E{(u8*)Y, (const float*)INP(22) + (size_t)layer * 32 * 1024, (const unsigned long long*)SLOT};
            pg8::gemm_phase<pg8::EpiDown, pg8::MoeOrderT<false>, MOE_FP8 != 0>(F.lds, HD, 1024 * MOE_EB, S, E); }
            { const int r7 = __builtin_amdgcn_readfirstlane(F.LC[102]), i7 = __builtin_amdgcn_readfirstlane(F.LC[103]), i6 = __builtin_amdgcn_readfirstlane(F.LC[101]);
              if (i7 > 0 && F.vcu >= r7) cvt_moe_stream(F, (const float*)INP(17), (const float*)INP(19), (const float*)INP(21), layer + 1, NXTBUF, i6 * NWAVES * CVT_QUOTA + (F.vcu - r7) * NWAVES + F.wave, i7 * NWAVES, CVT_QUOTA); }
        }
        SEAM(P + 7);
        if (IN(P + 8)) {
            const float* g2 = (const float*)INP(2) + (size_t)(layer * 2 + 1) * 1024; const float* b2 = (const float*)INP(3) + (size_t)(layer * 2 + 1) * 1024;
            const int lane = opq(F.lane); const bf16* H1p = (const bf16*)HF; float* hout = (float*)INP(23); const bool lastl = layer == 3; const u8* Yp = (const u8*)Y; bf16* HBp = HB;
            f32x4 lnG2[4], lnB2[4];
#pragma unroll
            for (int jx = 0; jx < 4; ++jx) { lnG2[jx] = *(const GAS f32x4*)(g2 + 4 * lane + 256 * jx); lnB2[jx] = *(const GAS f32x4*)(b2 + 4 * lane + 256 * jx); }
            for (int row0 = gw; row0 < NTOK; row0 += 4 * NGW) {
                int ya_[2][4][4], yc_[2][4][4]; u32x2 ha_[2][4], hc_[2][4]; int rws[2], rws2[2]; bool has[2], two_[2];
#pragma unroll
                for (int pr = 0; pr < 2; ++pr) { const int row = row0 + 2 * pr * NGW; has[pr] = row < NTOK; const int rowc = has[pr] ? row : gw; two_[pr] = has[pr] && (row + NGW < NTOK); const int row2 = two_[pr] ? row + NGW : rowc;
                    rws[pr] = rowc; rws2[pr] = row2;
#pragma unroll
                    for (int jx = 0; jx < 4; ++jx) { ha_[pr][jx] = *(const GAS u32x2*)(H1p + (size_t)rowc * 1024 + 4 * lane + 256 * jx); hc_[pr][jx] = *(const GAS u32x2*)(H1p + (size_t)row2 * 1024 + 4 * lane + 256 * jx);
#pragma unroll
                        for (int k = 0; k < 4; ++k) { ya_[pr][jx][k] = *(const GAS int*)(Yp + ((size_t)rowc * 4 + k) * 1024 + 4 * lane + 256 * jx); yc_[pr][jx][k] = *(const GAS int*)(Yp + ((size_t)row2 * 4 + k) * 1024 + 4 * lane + 256 * jx); } } }
#pragma unroll
                for (int pr = 0; pr < 2; ++pr) { if (!has[pr]) continue; const int row = rws[pr], row2 = rws2[pr]; const bool two = two_[pr];
                f32x4 va[4], vc[4];
#pragma unroll
                for (int jx = 0; jx < 4; ++jx) { const f32x4 ha = {bf_lo(ha_[pr][jx].x), bf_hi(ha_[pr][jx].x), bf_lo(ha_[pr][jx].y), bf_hi(ha_[pr][jx].y)}, hc = {bf_lo(hc_[pr][jx].x), bf_hi(hc_[pr][jx].x), bf_lo(hc_[pr][jx].y), bf_hi(hc_[pr][jx].y)};
                    f32x4 sa = {0.f, 0.f, 0.f, 0.f}, sc = {0.f, 0.f, 0.f, 0.f};
#pragma unroll
                    for (int k = 0; k < 4; ++k) { const int ya = ya_[pr][jx][k], yc = yc_[pr][jx][k];
                        const f32x2 a0 = __builtin_amdgcn_cvt_pk_f32_fp8(ya, false), a1 = __builtin_amdgcn_cvt_pk_f32_fp8(ya, true), c0 = __builtin_amdgcn_cvt_pk_f32_fp8(yc, false), c1 = __builtin_amdgcn_cvt_pk_f32_fp8(yc, true);
                        sa += (f32x4){a0.x, a0.y, a1.x, a1.y}; sc += (f32x4){c0.x, c0.y, c1.x, c1.y}; }
                    va[jx] = ha * DN_ALPHA + sa * 0.0625f; vc[jx] = hc * DN_ALPHA + sc * 0.0625f; }
                ln_pair_finish(va, vc, lnG2, lnB2);
#pragma unroll
                for (int jx = 0; jx < 4; ++jx) {
                    if (lastl) { *(GAS f32x4*)(hout + (size_t)row * 1024 + 4 * lane + 256 * jx) = va[jx]; if (two) *(GAS f32x4*)(hout + (size_t)row2 * 1024 + 4 * lane + 256 * jx) = vc[jx]; }
                    else { *(GAS u32x2*)(HBp + (size_t)row * 1024 + 4 * lane + 256 * jx) = (u32x2){pk2(va[jx].x, va[jx].y), pk2(va[jx].z, va[jx].w)};
                        if (two) *(GAS u32x2*)(HBp + (size_t)row2 * 1024 + 4 * lane + 256 * jx) = (u32x2){pk2(vc[jx].x, vc[jx].y), pk2(vc[jx].z, vc[jx].w)}; } }
                }
            }
        }
        SEAM(P + 8);
    }
#undef IN
#undef SEAM
#undef NXTBUF
#undef gw
#undef WSB
#undef HF
#undef HB
#undef AO
#undef MIX
#undef Y
#undef HD
#undef XS
#undef SLOT
#undef GATE
}

extern "C" void kernel_launch(void* const* d_in, const int* in_sizes, int n_in, void* d_out, int out_size, void* d_ws, size_t ws_size, hipStream_t stream) {
    static int grid = 0;
    if (grid == 0) {
        if (n_in != 23 || out_size != NTOK * DM || ws_size < WS_END) { fprintf(stderr, "kernel_launch: unexpected shapes (n_in %d out %d ws %zu, need %zu)\n", n_in, out_size, ws_size, (size_t)WS_END); grid = -1; return; }
        int dev = 0, cus = 0, per_cu = 0;
        if (hipGetDevice(&dev) != hipSuccess || hipDeviceGetAttribute(&cus, hipDeviceAttributeMultiprocessorCount, dev) != hipSuccess) { grid = -1; return; }
        if (hipFuncSetAttribute((const void*)mk_fwd, hipFuncAttributeMaxDynamicSharedMemorySize, LDS_BYTES) != hipSuccess) { fprintf(stderr, "kernel_launch: hipFuncSetAttribute failed\n"); grid = -1; return; }
        if (hipOccupancyMaxActiveBlocksPerMultiprocessor(&per_cu, (const void*)mk_fwd, NWAVES * 64, LDS_BYTES) != hipSuccess || per_cu < 1) { fprintf(stderr, "kernel_launch: occupancy query says %d\n", per_cu); }
        (void)hipGetLastError();
        grid = cus;
    }
    if (grid < 0) return;
    if (hipMemsetAsync((char*)d_ws + WS_CTL, 0, CTL_ZERO_BYTES, stream) != hipSuccess) return;
    Args a{};
    for (int i = 0; i < 23; ++i) a.in[i] = d_in[i];
    a.out = (float*)d_out; a.ws = (unsigned char*)d_ws;
#if MK_PER_PHASE
    for (int p = 0; p < N_PHASES; ++p) {
        const int layer = (p - 1) / PH_PER_LAYER, q = (p - 1) % PH_PER_LAYER;
        if (p > 0 && (layer % 3) != 2 && (q == 2 || q == 3)) continue;
        a.ph_lo = p; a.ph_hi = p + 1;
        hipLaunchKernelGGL(mk_fwd, dim3(grid), dim3(NWAVES * 64), LDS_BYTES, stream, a);
    }
#else
    a.ph_lo = 0; a.ph_hi = N_PHASES;
    hipLaunchKernelGGL(mk_fwd, dim3(grid), dim3(NWAVES * 64), LDS_BYTES, stream, a);
#endif
}
```
